# Optimizing an MI355X kernel written in HIP

```python
import jax
import jax.numpy as jnp
from jax import lax
import numpy as np

D_MODEL = 1024
BATCH = 4
SEQ = 4096
DEPTH = 2

GRID_W = 64
CTX_LEN = 256
HEAD_DIM = 64
NA_HEADS = 8
NA_WIN_R = 8
NA_WIN_C = 16
NA_QBLK_C = 16
NA_KBAND_C = 32
FN_GROUPS = 8
FN_GROUP_DIM = 64
WA_HEADS = 8
WA_KV_HEADS = 2
WA_WINDOW = 128
WA_BLOCK = 128
D_FF = 2816
N_BRANCH = 3
N_MOD = 9
ROPE_BASE = 10000.0
EPS = 1e-6
NEG_INF = -1e30

NA_W = NA_HEADS * HEAD_DIM
FN_W = FN_GROUPS * FN_GROUP_DIM
WA_QW = WA_HEADS * HEAD_DIM
WA_KVW = WA_KV_HEADS * HEAD_DIM
BRANCH_W = NA_W
O_NA_K = NA_W
O_NA_V = 2 * NA_W
O_FN = 3 * NA_W
O_WA_Q = O_FN + FN_W
O_WA_K = O_WA_Q + WA_QW
O_WA_V = O_WA_K + WA_KVW
O_GATE = O_WA_V + WA_KVW
P_IN = O_GATE + N_BRANCH * D_MODEL

kernel_name = "hybrid_natten_fnet_swa_prefix_dit"


def rmsnorm(x, g):
    xf = x.astype(jnp.float32)
    y = xf * lax.rsqrt(jnp.mean(xf * xf, axis=-1, keepdims=True) + EPS)
    return (y * g.astype(jnp.float32)).astype(x.dtype)


def modulate(x, shift, scale):
    return x * (1 + scale) + shift


def swiglu(u, w13, w2):
    a, b = jnp.split(u @ w13, 2, axis=-1)
    return (jax.nn.silu(a) * b) @ w2


def ffn_half_step(h, g, shift, scale, gate, w13, w2):
    return h + 0.5 * gate * swiglu(modulate(rmsnorm(h, g), shift, scale), w13, w2)


def heads(t, n):
    return t.reshape(*t.shape[:-1], n, HEAD_DIM)


def axial_rope(n_tok):
    t = jnp.arange(n_tok)
    row = (t // GRID_W).astype(jnp.float32)
    col = (t % GRID_W).astype(jnp.float32)
    n_freq = HEAD_DIM // 4
    inv = ROPE_BASE ** (-jnp.arange(n_freq, dtype=jnp.float32) / n_freq)
    ang = jnp.concatenate([row[:, None] * inv, col[:, None] * inv], axis=-1)
    return jnp.cos(ang), jnp.sin(ang)


def apply_rope(t, cos, sin):
    tf = t.astype(jnp.float32)
    t1, t2 = jnp.split(tf, 2, axis=-1)
    c = cos[:, None, :]
    s = sin[:, None, :]
    return jnp.concatenate([t1 * c - t2 * s, t1 * s + t2 * c], axis=-1).astype(t.dtype)


def split_projection(p):
    return jnp.split(p, [O_NA_K, O_NA_V, O_FN, O_WA_Q, O_WA_K, O_WA_V, O_GATE], axis=-1)


def neighbourhood_attention(q, k, v, kc, vc, bias_tab, rows):
    B, S, H, Dh = q.shape
    wr = min(NA_WIN_R, rows)
    n_cb = GRID_W // NA_QBLK_C
    r = jnp.arange(rows)
    row_start = jnp.clip(r - wr // 2, 0, rows - wr)
    key_rows = row_start[:, None] + jnp.arange(wr)
    cb = jnp.arange(n_cb)
    band_start = jnp.clip(cb * NA_QBLK_C - NA_WIN_C // 2, 0, GRID_W - NA_KBAND_C)
    key_cols = band_start[:, None] + jnp.arange(NA_KBAND_C)
    q_cols = cb[:, None] * NA_QBLK_C + jnp.arange(NA_QBLK_C)
    win_start = jnp.clip(q_cols - NA_WIN_C // 2, 0, GRID_W - NA_WIN_C)
    kcb = key_cols[:, None, :]
    in_win = (kcb >= win_start[..., None]) & (kcb < win_start[..., None] + NA_WIN_C)
    dr_idx = key_rows - r[:, None] + NA_WIN_R - 1
    dc_idx = jnp.clip(kcb - q_cols[..., None], -(NA_WIN_C - 1), NA_WIN_C - 1) + NA_WIN_C - 1
    bias = bias_tab[:, dr_idx[:, None, None, :, None], dc_idx[None, :, :, None, :]]
    bias = bias.astype(jnp.float32)

    kg = k.reshape(B, rows, GRID_W, H, Dh)
    vg = v.reshape(B, rows, GRID_W, H, Dh)
    ridx = key_rows[:, None, :, None]
    cidx = key_cols[None, :, None, :]
    kb = kg[:, ridx, cidx]
    vb = vg[:, ridx, cidx]
    qg = q.reshape(B, rows, n_cb, NA_QBLK_C, H, Dh)
    scale = Dh ** -0.5
    s_loc = jnp.einsum('brcqhd,brcwkhd->bhrcqwk', qg, kb).astype(jnp.float32) * scale + bias[None]
    s_loc = jnp.where(in_win[:, :, None, :], s_loc, NEG_INF)
    s_loc = s_loc.reshape(*s_loc.shape[:5], wr * NA_KBAND_C)
    s_ctx = jnp.einsum('brcqhd,blhd->bhrcql', qg, kc).astype(jnp.float32) * scale
    n_loc = wr * NA_KBAND_C
    p = jax.nn.softmax(jnp.concatenate([s_loc, s_ctx], axis=-1), axis=-1).astype(v.dtype)
    p_loc = p[..., :n_loc].reshape(*p.shape[:5], wr, NA_KBAND_C)
    p_ctx = p[..., n_loc:]
    o = jnp.einsum('bhrcqwk,brcwkhd->brcqhd', p_loc, vb) + jnp.einsum('bhrcql,blhd->brcqhd', p_ctx, vc)
    return o.reshape(B, S, H * Dh)


def window_gqa_attention(q, k, v, kc, vc, sink):
    B, S, Hq, Dh = q.shape
    Hkv = k.shape[2]
    G = Hq // Hkv
    nb = S // WA_BLOCK
    qb = q.reshape(B, nb, WA_BLOCK, Hkv, G, Dh)
    pad = ((0, 0), (WA_BLOCK, WA_BLOCK), (0, 0), (0, 0))
    kp = jnp.pad(k, pad)
    vp = jnp.pad(v, pad)
    idx = jnp.arange(nb)[:, None] * WA_BLOCK + jnp.arange(3 * WA_BLOCK)
    kb = kp[:, idx]
    vb = vp[:, idx]
    qpos = jnp.arange(S).reshape(nb, WA_BLOCK)
    kpos = (idx - WA_BLOCK)[:, None, :]
    valid = (jnp.abs(kpos - qpos[..., None]) <= WA_WINDOW) & (kpos >= 0) & (kpos < S)
    scale = Dh ** -0.5
    s_loc = jnp.einsum('bnqkgd,bnjkd->bkgnqj', qb, kb).astype(jnp.float32) * scale
    s_loc = jnp.where(valid, s_loc, NEG_INF)
    s_ctx = jnp.einsum('bnqkgd,blkd->bkgnql', qb, kc).astype(jnp.float32) * scale
    s_sink = jnp.broadcast_to(sink.astype(jnp.float32).reshape(1, Hkv, G, 1, 1, 1), s_loc.shape[:-1] + (1,))
    p = jax.nn.softmax(jnp.concatenate([s_loc, s_ctx, s_sink], axis=-1), axis=-1).astype(v.dtype)
    n_loc = 3 * WA_BLOCK
    n_ctx = kc.shape[1]
    o = (jnp.einsum('bkgnqj,bnjkd->bnqkgd', p[..., :n_loc], vb)
         + jnp.einsum('bkgnql,blkd->bnqkgd', p[..., n_loc:n_loc + n_ctx], vc))
    return o.reshape(B, S, Hq * Dh)


def context_attention(q, k, v, sink=None):
    B, L, Hq, Dh = q.shape
    Hkv = k.shape[2]
    G = Hq // Hkv
    qg = q.reshape(B, L, Hkv, G, Dh)
    s = jnp.einsum('bqkgd,bjkd->bkgqj', qg, k).astype(jnp.float32) * (Dh ** -0.5)
    if sink is None:
        p = jax.nn.softmax(s, axis=-1)
    else:
        s_sink = jnp.broadcast_to(sink.astype(jnp.float32).reshape(1, Hkv, G, 1, 1), s.shape[:-1] + (1,))
        p = jax.nn.softmax(jnp.concatenate([s, s_sink], axis=-1), axis=-1)[..., :L]
    o = jnp.einsum('bkgqj,bjkd->bqkgd', p.astype(v.dtype), v)
    return o.reshape(B, L, Hq * Dh)


def fourier_mix(u):
    B, N, _ = u.shape
    ug = u.reshape(B, N, FN_GROUPS, FN_GROUP_DIM).astype(jnp.float32)
    f = jnp.fft.fft2(ug, axes=(1, 3), norm='ortho').real
    return f.reshape(B, N, FN_W).astype(u.dtype)


def merge_branches(a, f, w, gate_logits, w_br, w_out):
    outs = jnp.stack([a, f, w], axis=-2)
    y = jnp.einsum('bnic,icd->bnid', outs, w_br)
    g = jax.nn.sigmoid(gate_logits.reshape(*gate_logits.shape[:-1], N_BRANCH, D_MODEL))
    return jnp.sum(g * y, axis=-2) @ w_out


def setup_inputs(seed: int = 0) -> dict:
    key = jax.random.key(seed)
    ks = jax.random.split(key, 19)
    D = D_MODEL

    def nrm(k, shape, scale):
        return jax.random.normal(k, shape, jnp.float32) * scale

    return {
        "x": nrm(ks[0], (BATCH, SEQ, D), 1.0),
        "c": nrm(ks[1], (BATCH, D), 1.0),
        "ctx": nrm(ks[2], (BATCH, CTX_LEN, D), 1.0),
        "c_ctx": nrm(ks[3], (D,), 1.0),
        "w_ada": nrm(ks[4], (DEPTH, D, N_MOD * D), D ** -0.5),
        "b_ada": nrm(ks[5], (DEPTH, N_MOD * D), 0.02),
        "g_ffn1": 1.0 + nrm(ks[6], (DEPTH, D), 0.02),
        "ffn1_w13": nrm(ks[7], (DEPTH, D, 2 * D_FF), D ** -0.5),
        "ffn1_w2": nrm(ks[8], (DEPTH, D_FF, D), D_FF ** -0.5),
        "g_mix": 1.0 + nrm(ks[9], (DEPTH, D), 0.02),
        "w_in": nrm(ks[10], (DEPTH, D, P_IN), D ** -0.5),
        "na_bias": nrm(ks[11], (DEPTH, NA_HEADS, 2 * NA_WIN_R - 1, 2 * NA_WIN_C - 1), 0.1),
        "wa_sink": nrm(ks[12], (DEPTH, WA_HEADS), 1.0),
        "w_br": nrm(ks[13], (DEPTH, N_BRANCH, BRANCH_W, D), BRANCH_W ** -0.5),
        "w_out": nrm(ks[14], (DEPTH, D, D), D ** -0.5),
        "g_ffn2": 1.0 + nrm(ks[15], (DEPTH, D), 0.02),
        "ffn2_w13": nrm(ks[16], (DEPTH, D, 2 * D_FF), D ** -0.5),
        "ffn2_w2": nrm(ks[17], (DEPTH, D_FF, D), D_FF ** -0.5),
        "g_final": 1.0 + nrm(ks[18], (D,), 0.02),
    }


def reference(x, c, ctx, c_ctx, w_ada, b_ada, g_ffn1, ffn1_w13, ffn1_w2, g_mix, w_in, na_bias, wa_sink,
              w_br, w_out, g_ffn2, ffn2_w13, ffn2_w2, g_final):
    S = x.shape[1]
    rows = S // GRID_W
    cos, sin = axial_rope(S)
    h, hc = x, ctx
    for l in range(DEPTH):
        last = l == DEPTH - 1
        mod = (jax.nn.silu(c) @ w_ada[l] + b_ada[l])[:, None, :]
        mod_c = jax.nn.silu(c_ctx) @ w_ada[l] + b_ada[l]
        sh1, sc1, gt1, sh2, sc2, gt2, sh3, sc3, gt3 = jnp.split(mod, N_MOD, axis=-1)
        csh1, csc1, cgt1, csh2, csc2, cgt2, csh3, csc3, cgt3 = jnp.split(mod_c, N_MOD, axis=-1)

        h = ffn_half_step(h, g_ffn1[l], sh1, sc1, gt1, ffn1_w13[l], ffn1_w2[l])
        hc = ffn_half_step(hc, g_ffn1[l], csh1, csc1, cgt1, ffn1_w13[l], ffn1_w2[l])

        u = modulate(rmsnorm(h, g_mix[l]), sh2, sc2)
        uc = modulate(rmsnorm(hc, g_mix[l]), csh2, csc2)
        nq, nk, nv, fu, wq, wk, wv, gl = split_projection(u @ w_in[l])
        if last:
            cnk, cnv = jnp.split(uc @ w_in[l][:, O_NA_K:O_FN], 2, axis=-1)
            cwk, cwv = jnp.split(uc @ w_in[l][:, O_WA_K:O_GATE], 2, axis=-1)
        else:
            cnq, cnk, cnv, cfu, cwq, cwk, cwv, cgl = split_projection(uc @ w_in[l])
        nk_c, nv_c = heads(cnk, NA_HEADS), heads(cnv, NA_HEADS)
        wk_c, wv_c = heads(cwk, WA_KV_HEADS), heads(cwv, WA_KV_HEADS)

        a = neighbourhood_attention(heads(nq, NA_HEADS), heads(nk, NA_HEADS), heads(nv, NA_HEADS),
                                    nk_c, nv_c, na_bias[l], rows)
        f = fourier_mix(fu)
        w = window_gqa_attention(apply_rope(heads(wq, WA_HEADS), cos, sin),
                                 apply_rope(heads(wk, WA_KV_HEADS), cos, sin),
                                 heads(wv, WA_KV_HEADS), wk_c, wv_c, wa_sink[l])
        h = h + gt2 * merge_branches(a, f, w, gl, w_br[l], w_out[l])

        if not last:
            ca = context_attention(heads(cnq, NA_HEADS), nk_c, nv_c)
            cf = fourier_mix(cfu)
            cw = context_attention(heads(cwq, WA_HEADS), wk_c, wv_c, wa_sink[l])
            hc = hc + cgt2 * merge_branches(ca, cf, cw, cgl, w_br[l], w_out[l])
            hc = ffn_half_step(hc, g_ffn2[l], csh3, csc3, cgt3, ffn2_w13[l], ffn2_w2[l])

        h = ffn_half_step(h, g_ffn2[l], sh3, sc3, gt3, ffn2_w13[l], ffn2_w2[l])
    return rmsnorm(h, g_final)
```

```cpp
#include <hip/hip_runtime.h>
#include <hip/hip_cooperative_groups.h>
#include <cstdio>
#include <cstdint>
namespace cg = cooperative_groups;

#ifndef MK_MULTI
#define MK_MULTI 0
#endif

#ifndef NULLMASK
#define NULLMASK 0u
#endif
#ifndef REPMASK
#define REPMASK 0u
#endif
#define LAS __attribute__((address_space(3)))
typedef unsigned short bf16_t;
typedef short bf16x8 __attribute__((ext_vector_type(8)));
typedef short s16x4 __attribute__((ext_vector_type(4)));
typedef float f32x4 __attribute__((ext_vector_type(4)));
typedef float f32x2 __attribute__((ext_vector_type(2)));
typedef unsigned u32x4 __attribute__((ext_vector_type(4)));
typedef unsigned u32x2 __attribute__((ext_vector_type(2)));

constexpr int DM = 1024, NBATCH = 4, SEQ = 4096, ML = NBATCH * SEQ, CTXL = 256, MC = NBATCH * CTXL, MT = ML + MC;
constexpr int DFF = 2816, PIN = 5888, NMODC = 9 * DM;
constexpr int PW = 1792;
constexpr int VTR = 1792;
constexpr int BRW = 1536;
constexpr int GLW = 3072;
constexpr float EPS = 1e-6f;

constexpr size_t MiB = 1u << 20;
constexpr size_t WS_MOD = 64 * 1024;
constexpr size_t WS_ROPE = 512 * 1024;
constexpr size_t WS_TW = 640 * 1024;
constexpr size_t WS_FB1 = 768 * 1024;
constexpr size_t WS_A3 = 896 * 1024;
constexpr size_t WS_SM = 1 * MiB;
constexpr int SM_GF1 = 0, SM_GMIX = 2048, SM_GF2 = 4096, SM_GFIN = 6144, SM_SINK = 7168, SM_BIAS = 7232, SM_END = 7232 + 7440;
constexpr size_t WS_W = 2 * MiB, WS_WL = 52 * MiB;
constexpr size_t WO_13A = 0, WO_2A = 11 * MiB, WO_IN = WO_2A + 11 * MiB / 2, WO_INT = WO_IN + 7 * MiB / 2, WO_G = WO_INT + 7 * MiB / 2,
                 WO_BR = WO_G + 6 * MiB, WO_OUT = WO_BR + 3 * MiB, WO_13B = WO_OUT + 2 * MiB, WO_2B = WO_13B + 11 * MiB;
static_assert(WO_2B + 11 * MiB / 2 <= WS_WL, "weights");
constexpr size_t WS_HC = 106 * MiB;
constexpr size_t WS_U = 110 * MiB;
constexpr size_t WS_BR = 144 * MiB;
constexpr size_t WS_R1 = 195 * MiB;
constexpr size_t WS_VT = WS_R1 + (size_t)MT * PW * 2;
constexpr size_t WS_END = WS_R1 + 119 * MiB;
static_assert((size_t)MT * GLW * 2 <= 119 * MiB && (size_t)MT * DFF * 2 <= 119 * MiB && (size_t)MT * PW * 4 <= 119 * MiB, "R1");

constexpr int LDS_BYTES = 163840;
constexpr int LDS_X = 131072;

__device__ __forceinline__ int lane_now() { int l; asm volatile("v_mbcnt_lo_u32_b32 %0, -1, 0\n\tv_mbcnt_hi_u32_b32 %0, -1, %0" : "=v"(l)); return l; }
__device__ __forceinline__ unsigned f2bf(float f) { unsigned u = __builtin_bit_cast(unsigned, f); return (u + 0x7fffu + ((u >> 16) & 1u)) >> 16; }
typedef __bf16 bf16x2_t __attribute__((ext_vector_type(2)));
__device__ __forceinline__ unsigned pk2(float lo, float hi) { const f32x2 v = {lo, hi}; const bf16x2_t b = __builtin_convertvector(v, bf16x2_t); return __builtin_bit_cast(unsigned, b); }
__device__ __forceinline__ float bf2f(unsigned short b) { return __builtin_bit_cast(float, (unsigned)b << 16); }
__device__ __forceinline__ float bflo(unsigned w) { return __builtin_bit_cast(float, w << 16); }
__device__ __forceinline__ float bfhi(unsigned w) { return __builtin_bit_cast(float, w & 0xffff0000u); }
__device__ __forceinline__ float wave_sum(float v) {
#pragma unroll
    for (int o = 1; o < 64; o <<= 1) v += __shfl_xor(v, o);
    return v;
}
__device__ __forceinline__ void sincos_turns(double t, float& s, float& c) {
    const double k = __builtin_rint(t * 4.0); const double r = (t - k * 0.25) * 6.283185307179586476925;
    const double r2 = r * r;
    const double sp = r * (1.0 + r2 * (-1.0 / 6 + r2 * (1.0 / 120 + r2 * (-1.0 / 5040 + r2 * (1.0 / 362880 + r2 * (-1.0 / 39916800 + r2 * (1.0 / 6227020800.0)))))));
    const double cp = 1.0 + r2 * (-0.5 + r2 * (1.0 / 24 + r2 * (-1.0 / 720 + r2 * (1.0 / 40320 + r2 * (-1.0 / 3628800 + r2 * (1.0 / 479001600.0 + r2 * (-1.0 / 87178291200.0)))))));
    const int q = ((int)k) & 3;
    const double ss = (q == 0) ? sp : (q == 1) ? cp : (q == 2) ? -sp : -cp;
    const double cc = (q == 0) ? cp : (q == 1) ? -sp : (q == 2) ? -cp : sp;
    s = (float)ss; c = (float)cc;
}

namespace pg8 {
constexpr int BM = 256, BK = 64, HALF = 128, HTB = HALF * BK * 2, STAGE_BYTES = 8 * HTB, NXCD = 8, WGM = 8;
__device__ __forceinline__ int lds_byte(int r, int c) { const int st = (r >> 4) * 2 + (c >> 5), rr = r & 15, cc = c & 31, ob = rr * 64 + cc * 2; return st * 1024 + (ob ^ (((ob >> 9) & 1) << 5)); }
__device__ __forceinline__ void stage_rc(int b, int& R, int& C) { const int st = b / 1024, sb = b % 1024, swz = sb ^ (((sb >> 9) & 1) << 5); R = (st >> 1) * 16 + swz / 64; C = (st & 1) * 32 + (swz % 64) / 2; }
__device__ __forceinline__ int perm32(int rho) { const int n = rho >> 4, i = rho & 15; return 8 * (i >> 2) + 4 * n + (i & 3); }

struct Unit { int pm, pn, kind; const char* A; const char* B; };

__device__ __forceinline__ void tile_map(int L, int nM, int nN, int& pm, int& pn) {
    const int nwg = nM * nN; int wgid = L;
    { const int q = nwg / NXCD, r = nwg % NXCD, xcd = wgid % NXCD, off = wgid / NXCD; wgid = (xcd < r ? xcd * (q + 1) : r * (q + 1) + (xcd - r) * q) + off; }
    const int nig = WGM * nN, gid = wgid / nig, fm = gid * WGM, gsz = (nM - fm) < WGM ? (nM - fm) : WGM;
    pm = fm + ((wgid % nig) % gsz); pn = (wgid % nig) / gsz;
}

template <class Epi, class Sched>
__device__ __forceinline__ void gemm_phase(const int wv_, LAS unsigned char* lds, const int K, const int lda, const int ldb, const Sched& S, const Epi& E) {
    const int lane = lane_now(), wid = wv_, tid = wid * 64 + lane, wr = wid >> 2, wc = wid & 3, fr = lane & 15, fq = lane >> 4;
    const int nt = K / BK;
    unsigned voffA[2], voffB[2];
#pragma unroll
    for (int i = 0; i < 2; ++i) { int R, C; stage_rc(tid * 16 + i * 8192, R, C); const int Rb = Epi::PERM ? ((R & ~31) + perm32(R & 31)) : R;
        voffA[i] = (unsigned)(R * lda + C) * 2u; voffB[i] = (unsigned)(Rb * ldb + C) * 2u; }
    const size_t kstep = (size_t)(BK * 2);
    const size_t hstepA = (size_t)HALF * lda * 2, hstepB = (size_t)HALF * ldb * 2;
    const unsigned ldsw = (unsigned)wid * 1024u;
    const int aoff = lds_byte(wr * 64 + fr, fq * 8), boff = lds_byte(wc * 32 + fr, fq * 8);
#define PG8_SA(b, h) (((b) * 2 + (h)) * HTB)
#define PG8_SB(b, h) ((4 + (b) * 2 + (h)) * HTB)
#define PG8_STAGE(bufoff, gbase, voff) do { _Pragma("unroll") for (int _i = 0; _i < 2; ++_i) \
        __builtin_amdgcn_global_load_lds((const unsigned*)((const char*)(gbase) + (voff)[_i]), (LAS unsigned*)(lds + (bufoff) + ldsw + _i * 8192), 16, 0, 0); } while (0)
#define PG8_LDA(dst, b, h) do { _Pragma("unroll") for (int m = 0; m < 4; ++m) _Pragma("unroll") for (int k = 0; k < 2; ++k) dst[m][k] = *(const LAS bf16x8*)(lds + PG8_SA(b, h) + aoff + m * 2048 + k * 1024); } while (0)
#define PG8_LDB(dst, b, h) do { _Pragma("unroll") for (int n = 0; n < 2; ++n) _Pragma("unroll") for (int k = 0; k < 2; ++k) dst[n][k] = *(const LAS bf16x8*)(lds + PG8_SB(b, h) + boff + n * 2048 + k * 1024); } while (0)
#define PG8_MMA(ai, bj, At, Bt) do { __builtin_amdgcn_s_setprio(1); _Pragma("unroll") for (int m = 0; m < 4; ++m) _Pragma("unroll") for (int n = 0; n < 2; ++n) _Pragma("unroll") for (int k = 0; k < 2; ++k) \
        acc[ai][bj][m][n] = __builtin_amdgcn_mfma_f32_16x16x32_bf16(Bt[n][k], At[m][k], acc[ai][bj][m][n], 0, 0, 0); __builtin_amdgcn_s_setprio(0); } while (0)
#define PG8_WAIT_V(n) asm volatile("s_waitcnt vmcnt(" #n ")" ::: "memory")
#define PG8_WAIT_L(n) asm volatile("s_waitcnt lgkmcnt(" #n ")" ::: "memory")
#define PG8_BAR __builtin_amdgcn_s_barrier()
#define PG8_SCHED __builtin_amdgcn_sched_barrier(0)
    Unit cur, nxt; int ui = 0;
    if (!S.next(0, cur)) return;
    f32x4 acc[2][2][4][2];
#pragma unroll
    for (int a = 0; a < 2; ++a)
#pragma unroll
        for (int b = 0; b < 2; ++b)
#pragma unroll
            for (int m = 0; m < 4; ++m)
#pragma unroll
                for (int n = 0; n < 2; ++n) acc[a][b][m][n] = (f32x4){0.f, 0.f, 0.f, 0.f};
    bf16x8 At[4][2], B0[2][2], B1[2][2];
    const char* cA = cur.A; const char* cB = cur.B;
    PG8_STAGE(PG8_SB(0, 0), cB, voffB); PG8_STAGE(PG8_SB(0, 1), cB + hstepB, voffB); PG8_STAGE(PG8_SA(0, 0), cA, voffA); PG8_STAGE(PG8_SA(0, 1), cA + hstepA, voffA);
    if (wr == 1) PG8_BAR;
    PG8_WAIT_V(2); PG8_BAR;
    PG8_STAGE(PG8_SB(1, 0), cB + kstep, voffB); PG8_STAGE(PG8_SA(1, 0), cA + kstep, voffA); PG8_STAGE(PG8_SB(1, 1), cB + hstepB + kstep, voffB);
    PG8_WAIT_V(6); PG8_BAR;
    for (;;) {
        const bool has_next = S.next(ui + 1, nxt);
        const char* nA = has_next ? nxt.A : cA; const char* nB = has_next ? nxt.B : cB;
        for (int t = 0; t < nt; t += 2) {
            const bool last = (t == nt - 2);
            const char* a1 = cA + (size_t)(t + 1) * kstep;
            const char* a2 = last ? nA : cA + (size_t)(t + 2) * kstep; const char* b2 = last ? nB : cB + (size_t)(t + 2) * kstep;
            const char* a3 = a2 + kstep; const char* b3 = b2 + kstep;
            PG8_LDB(B0, 0, 0); PG8_LDB(B1, 0, 1); PG8_SCHED; PG8_LDA(At, 0, 0); PG8_STAGE(PG8_SA(1, 1), a1 + hstepA, voffA);
            PG8_WAIT_V(8); PG8_WAIT_L(0); PG8_BAR; PG8_MMA(0, 0, At, B0); PG8_MMA(0, 1, At, B1); PG8_BAR; PG8_SCHED;
            PG8_LDA(At, 0, 1); PG8_STAGE(PG8_SB(0, 0), b2, voffB); PG8_STAGE(PG8_SB(0, 1), b2 + hstepB, voffB); PG8_STAGE(PG8_SA(0, 0), a2, voffA);
            PG8_WAIT_V(8); PG8_WAIT_L(0); PG8_BAR; PG8_MMA(1, 0, At, B0); PG8_MMA(1, 1, At, B1); PG8_BAR; PG8_SCHED;
            PG8_LDB(B0, 1, 0); PG8_LDB(B1, 1, 1); PG8_SCHED; PG8_LDA(At, 1, 0); PG8_STAGE(PG8_SA(0, 1), a2 + hstepA, voffA);
            PG8_WAIT_V(8); PG8_WAIT_L(0); PG8_BAR; PG8_MMA(0, 0, At, B0); PG8_MMA(0, 1, At, B1); PG8_BAR; PG8_SCHED;
            PG8_LDA(At, 1, 1); PG8_STAGE(PG8_SB(1, 0), b3, voffB); PG8_STAGE(PG8_SB(1, 1), b3 + hstepB, voffB); PG8_STAGE(PG8_SA(1, 0), a3, voffA);
            PG8_WAIT_V(8); PG8_WAIT_L(0); PG8_BAR; PG8_MMA(1, 0, At, B0); PG8_MMA(1, 1, At, B1); PG8_BAR; PG8_SCHED;
        }
        if (wr == 0) PG8_BAR;
        E(acc, cur, wr, wc, fr, fq);
        if (!has_next) break;
#pragma unroll
        for (int a = 0; a < 2; ++a)
#pragma unroll
            for (int b = 0; b < 2; ++b)
#pragma unroll
                for (int m = 0; m < 4; ++m)
#pragma unroll
                    for (int n = 0; n < 2; ++n) acc[a][b][m][n] = (f32x4){0.f, 0.f, 0.f, 0.f};
        cur = nxt; cA = nA; cB = nB; ++ui;
        if (wr == 1) PG8_BAR;
    }
    PG8_WAIT_V(0);
    PG8_BAR;
#undef PG8_SA
#undef PG8_SB
#undef PG8_STAGE
#undef PG8_LDA
#undef PG8_LDB
#undef PG8_MMA
#undef PG8_WAIT_V
#undef PG8_WAIT_L
#undef PG8_BAR
#undef PG8_SCHED
}

struct Sched2 {
    int G, c;
    int n0, nM0, nN0; const char* A0; const char* B0; size_t at0, bt0;
    int n1, nM1, nN1; const char* A1; const char* B1; size_t at1, bt1;
    __device__ __forceinline__ bool next(int i, Unit& u) const {
        long L = (long)i * G + c;
        if (L < n0) { tile_map((int)L, nM0, nN0, u.pm, u.pn); u.kind = 0; u.A = A0 + (size_t)u.pm * at0; u.B = B0 + (size_t)u.pn * bt0; return true; }
        L -= n0;
        if (L < n1) { tile_map((int)L, nM1, nN1, u.pm, u.pn); u.kind = 1; u.A = A1 + (size_t)u.pm * at1; u.B = B1 + (size_t)u.pn * bt1; return true; }
        return false;
    }
};
struct SchedMerge {
    int G, c, nM; const char* BR; const char* WBR;
    __device__ __forceinline__ bool next(int i, Unit& u) const {
        const int rnd = i / 3, br = i - 3 * rnd; const long L = (long)rnd * G + c;
        if (L >= (long)nM * 4) return false;
        tile_map((int)L, nM, 4, u.pm, u.pn); u.kind = br;
        u.A = BR + (size_t)u.pm * 256 * BRW * 2 + (size_t)br * 512 * 2;
        u.B = WBR + (size_t)(br * 4 + u.pn) * 256 * 512 * 2;
        return true;
    }
};

struct SchedSplit {
    int G, c, nks; const char* A; const char* B; size_t lda2, ldb2;
    int kq_per; size_t abr;
    __device__ __forceinline__ bool next(int i, Unit& u) const {
        const long L = (long)i * G + c; if (L >= (long)16 * nks) return false;
        const int t = (int)L / nks, ks = (int)L - t * nks; u.pm = t >> 2; u.pn = t & 3; u.kind = ks;
        const int br = ks / kq_per, kq = ks - br * kq_per;
        u.A = A + (size_t)br * abr + (size_t)u.pm * 256 * lda2 + (size_t)kq * 512; u.B = B + (size_t)u.pn * 256 * ldb2 + (size_t)kq * 512; return true;
    }
};
struct SchedMergeCtx {
    int G, c; const char* BR; const char* WBR;
    __device__ __forceinline__ bool next(int i, Unit& u) const {
        const long L = (long)i * G + c; if (L >= 48) return false;
        const int t = (int)L / 3, br = (int)L - 3 * t; u.pm = 64 + (t >> 2); u.pn = t & 3; u.kind = br;
        u.A = BR + (size_t)u.pm * 256 * BRW * 2 + (size_t)br * 512 * 2;
        u.B = WBR + (size_t)(br * 4 + u.pn) * 256 * 512 * 2;
        return true;
    }
};
struct EpiNull { static constexpr bool PERM = false; float* sink;
    __device__ __forceinline__ void operator()(const f32x4 (&acc)[2][2][4][2], const Unit& u, int wr, int wc, int fr, int fq) const {
        f32x4 t = (f32x4){0.f, 0.f, 0.f, 0.f};
#pragma unroll
        for (int ai = 0; ai < 2; ++ai)
#pragma unroll
            for (int bj = 0; bj < 2; ++bj)
#pragma unroll
                for (int m = 0; m < 4; ++m)
#pragma unroll
                    for (int n = 0; n < 2; ++n) t = t + acc[ai][bj][m][n];
        const float q = (t[0] + t[1]) + (t[2] + t[3]);
        if (q == 1.2345678e33f) *sink = q; } };
struct EpiNullP { static constexpr bool PERM = true; float* sink;
    __device__ __forceinline__ void operator()(const f32x4 (&acc)[2][2][4][2], const Unit& u, int wr, int wc, int fr, int fq) const {
        f32x4 t = (f32x4){0.f, 0.f, 0.f, 0.f};
#pragma unroll
        for (int ai = 0; ai < 2; ++ai)
#pragma unroll
            for (int bj = 0; bj < 2; ++bj)
#pragma unroll
                for (int m = 0; m < 4; ++m)
#pragma unroll
                    for (int n = 0; n < 2; ++n) t = t + acc[ai][bj][m][n];
        const float q = (t[0] + t[1]) + (t[2] + t[3]);
        if (q == 1.2345678e33f) *sink = q; } };
struct EpiPart {
    static constexpr bool PERM = true;
    float* PART;
    __device__ __forceinline__ void operator()(const f32x4 (&acc)[2][2][4][2], const Unit& u, int wr, int wc, int fr_, int fq) const {
        int fr = fr_; asm volatile("" : "+v"(fr));
        float* base = PART + ((size_t)u.kind * MC + (size_t)u.pm * BM) * DM;
        const int row0 = wr * 64 + fr; const int col0 = u.pn * BM + wc * 32 + 8 * fq;
#pragma unroll
        for (int ai = 0; ai < 2; ++ai)
#pragma unroll
            for (int m = 0; m < 4; ++m) { float* rowp = base + (size_t)(row0 + ai * HALF + m * 16) * DM + col0;
#pragma unroll
                for (int bj = 0; bj < 2; ++bj) { *(f32x4*)(rowp + bj * HALF) = acc[ai][bj][m][0]; *(f32x4*)(rowp + bj * HALF + 4) = acc[ai][bj][m][1]; } }
    }
};

__device__ __forceinline__ float silu_f(float a) { return a * __builtin_amdgcn_rcpf(1.f + __expf(-a)); }
__device__ __forceinline__ float sigmoid_f(float a) { return __builtin_amdgcn_rcpf(1.f + __expf(-a)); }

struct EpiUp {
    static constexpr bool PERM = true;
    bf16_t* ACT;
    __device__ __forceinline__ void operator()(const f32x4 (&acc)[2][2][4][2], const Unit& u, int wr, int wc, int fr_, int fq) const {
        int fr = fr_; asm volatile("" : "+v"(fr));
        const int row0 = u.pm * BM + wr * 64 + fr; const int col0 = u.pn * 128 + wc * 32 + 8 * fq;
#pragma unroll
        for (int ai = 0; ai < 2; ++ai)
#pragma unroll
            for (int m = 0; m < 4; ++m) {
                bf16_t* rowp = ACT + (size_t)(row0 + ai * HALF + m * 16) * DFF + col0;
                float v[8];
#pragma unroll
                for (int n = 0; n < 2; ++n)
#pragma unroll
                    for (int j = 0; j < 4; ++j) v[4 * n + j] = silu_f(acc[ai][0][m][n][j]) * acc[ai][1][m][n][j];
                u32x4 w; w.x = pk2(v[0], v[1]); w.y = pk2(v[2], v[3]); w.z = pk2(v[4], v[5]); w.w = pk2(v[6], v[7]);
                *(u32x4*)rowp = w;
            }
    }
};
struct EpiRes {
    static constexpr bool PERM = true;
    bf16_t* HL; bf16_t* HCx; const float* gate;
    float coef; bf16_t* HLw;
    __device__ __forceinline__ void operator()(const f32x4 (&acc)[2][2][4][2], const Unit& u, int wr, int wc, int fr_, int fq) const {
        int fr = fr_; asm volatile("" : "+v"(fr));
        bf16_t* base = u.pm < 64 ? HL + (size_t)u.pm * BM * DM : HCx + (size_t)(u.pm - 64) * BM * DM;
        const int bidx = u.pm < 64 ? (u.pm >> 4) : 4;
        const float* gp = gate + (size_t)bidx * NMODC;
        const int row0 = wr * 64 + fr; const int col0 = u.pn * BM + wc * 32 + 8 * fq;
        bf16_t* wbase = u.pm < 64 ? HLw + (size_t)u.pm * BM * DM : base;
#pragma unroll
        for (int bj = 0; bj < 2; ++bj) {
            const f32x4 g0 = *(const f32x4*)(gp + col0 + bj * HALF) * coef, g1 = *(const f32x4*)(gp + col0 + bj * HALF + 4) * coef;
            u32x4 hv[2][4];
#pragma unroll
            for (int ai = 0; ai < 2; ++ai)
#pragma unroll
                for (int m = 0; m < 4; ++m) hv[ai][m] = *(const u32x4*)(base + (size_t)(row0 + ai * HALF + m * 16) * DM + col0 + bj * HALF);
#pragma unroll
            for (int ai = 0; ai < 2; ++ai)
#pragma unroll
                for (int m = 0; m < 4; ++m) { const f32x4 a0 = acc[ai][bj][m][0], a1 = acc[ai][bj][m][1]; const u32x4 h = hv[ai][m]; u32x4 w;
                    w.x = pk2(bflo(h.x) + g0[0] * a0[0], bfhi(h.x) + g0[1] * a0[1]); w.y = pk2(bflo(h.y) + g0[2] * a0[2], bfhi(h.y) + g0[3] * a0[3]);
                    w.z = pk2(bflo(h.z) + g1[0] * a1[0], bfhi(h.z) + g1[1] * a1[1]); w.w = pk2(bflo(h.w) + g1[2] * a1[2], bfhi(h.w) + g1[3] * a1[3]);
                    *(u32x4*)(wbase + (size_t)(row0 + ai * HALF + m * 16) * DM + col0 + bj * HALF) = w; }
        }
    }
};
struct EpiWin {
    static constexpr bool PERM = true;
    bf16_t* P; bf16_t* VT; const float* rope;
    __device__ __forceinline__ void operator()(const f32x4 (&acc)[2][2][4][2], const Unit& u, int wr, int wc, int fr_, int fq) const {
        int fr = fr_; asm volatile("" : "+v"(fr));
        const int row0 = u.pm * BM + wr * 64 + fr;
        if (u.kind == 0) {
            const bool rp = (u.pm < 64) && (u.pn == 4 || u.pn == 5 || (u.pn == 6 && wc < 2));
            const int colb = u.pn * BM + wc * 64 + 8 * fq;
#pragma unroll
            for (int ai = 0; ai < 2; ++ai)
#pragma unroll
                for (int m = 0; m < 4; ++m) {
                    const int row = row0 + ai * HALF + m * 16;
                    float x1[8], x2[8];
#pragma unroll
                    for (int n = 0; n < 2; ++n)
#pragma unroll
                        for (int j = 0; j < 4; ++j) { x1[4 * n + j] = acc[ai][0][m][n][j]; x2[4 * n + j] = acc[ai][1][m][n][j]; }
                    if (rp) {
                        const int t = row & 4095; const int pos = (fq < 2) ? (t >> 6) : (t & 63);
                        const f32x4* rt = (const f32x4*)(rope + ((size_t)pos * 16 + (fq & 1) * 8) * 2);
#pragma unroll
                        for (int q = 0; q < 4; ++q) { const f32x4 cs = rt[q];
                            const float a0 = x1[2 * q], b0 = x2[2 * q], a1 = x1[2 * q + 1], b1 = x2[2 * q + 1];
                            x1[2 * q] = a0 * cs[0] - b0 * cs[1]; x2[2 * q] = a0 * cs[1] + b0 * cs[0];
                            x1[2 * q + 1] = a1 * cs[2] - b1 * cs[3]; x2[2 * q + 1] = a1 * cs[3] + b1 * cs[2]; }
                    }
                    bf16_t* rowp = P + (size_t)row * PW + colb;
                    u32x4 w; w.x = pk2(x1[0], x1[1]); w.y = pk2(x1[2], x1[3]); w.z = pk2(x1[4], x1[5]); w.w = pk2(x1[6], x1[7]);
                    *(u32x4*)rowp = w;
                    w.x = pk2(x2[0], x2[1]); w.y = pk2(x2[2], x2[3]); w.z = pk2(x2[4], x2[5]); w.w = pk2(x2[6], x2[7]);
                    *(u32x4*)(rowp + 32) = w;
                }
        } else {
            const int col0 = u.pn * BM + wc * 32 + 8 * fq;
#pragma unroll
            for (int ai = 0; ai < 2; ++ai)
#pragma unroll
                for (int m = 0; m < 4; ++m) {
                    const int r = row0 + ai * HALF + m * 16;
                    if (u.pm < 3) {
                        bf16_t* vp = VT + (size_t)(r >> 6) * ((size_t)MT * 64) + (size_t)(col0 >> 2) * 256 + (r & 63) * 4;
#pragma unroll
                        for (int bj = 0; bj < 2; ++bj) { const f32x4 v0 = acc[ai][bj][m][0], v1 = acc[ai][bj][m][1];
                            u32x2 w; w.x = pk2(v0[0], v0[1]); w.y = pk2(v0[2], v0[3]); *(u32x2*)(vp + bj * 32 * 256) = w;
                            w.x = pk2(v1[0], v1[1]); w.y = pk2(v1[2], v1[3]); *(u32x2*)(vp + bj * 32 * 256 + 256) = w; }
                    } else {
                    bf16_t* rowp = VT + (size_t)r * MT + col0;
#pragma unroll
                    for (int bj = 0; bj < 2; ++bj) { const f32x4 v0 = acc[ai][bj][m][0], v1 = acc[ai][bj][m][1];
                        u32x4 w; w.x = pk2(v0[0], v0[1]); w.y = pk2(v0[2], v0[3]); w.z = pk2(v1[0], v1[1]); w.w = pk2(v1[2], v1[3]);
                        *(u32x4*)(rowp + bj * HALF) = w; }
                    }
                }
        }
    }
};
struct EpiGate {
    static constexpr bool PERM = true;
    bf16_t* GL;
    __device__ __forceinline__ void operator()(const f32x4 (&acc)[2][2][4][2], const Unit& u, int wr, int wc, int fr_, int fq) const {
        int fr = fr_; asm volatile("" : "+v"(fr));
        const int row0 = u.pm * BM + wr * 64 + fr; const int col0 = u.pn * BM + wc * 32 + 8 * fq;
#pragma unroll
        for (int ai = 0; ai < 2; ++ai)
#pragma unroll
            for (int m = 0; m < 4; ++m) {
                bf16_t* rowp = GL + (size_t)(row0 + ai * HALF + m * 16) * GLW + col0;
#pragma unroll
                for (int bj = 0; bj < 2; ++bj) { const f32x4 v0 = acc[ai][bj][m][0], v1 = acc[ai][bj][m][1];
                    u32x4 w; w.x = pk2(sigmoid_f(v0[0]), sigmoid_f(v0[1])); w.y = pk2(sigmoid_f(v0[2]), sigmoid_f(v0[3]));
                    w.z = pk2(sigmoid_f(v1[0]), sigmoid_f(v1[1])); w.w = pk2(sigmoid_f(v1[2]), sigmoid_f(v1[3]));
                    *(u32x4*)(rowp + bj * HALF) = w; }
            }
    }
};
struct EpiMerge {
    static constexpr bool PERM = true;
    const bf16_t* GL; bf16_t* MG; bf16_t* MGP;
    __device__ __forceinline__ void operator()(const f32x4 (&acc)[2][2][4][2], const Unit& u, int wr, int wc, int fr_, int fq) const {
        int fr = fr_; asm volatile("" : "+v"(fr));
        const int row0 = u.pm * BM + wr * 64 + fr; const int col0 = u.pn * BM + wc * 32 + 8 * fq;
#pragma unroll
        for (int ai = 0; ai < 2; ++ai)
#pragma unroll
            for (int m = 0; m < 4; ++m) {
                const size_t row = (size_t)(row0 + ai * HALF + m * 16);
#pragma unroll
                for (int bj = 0; bj < 2; ++bj) {
                    const u32x4 g = *(const u32x4*)(GL + row * GLW + u.kind * 1024 + col0 + bj * HALF);
                    u32x4* mp = MGP ? (u32x4*)(MGP + ((size_t)u.kind * MC + (row - ML)) * DM + col0 + bj * HALF) : (u32x4*)(MG + row * DM + col0 + bj * HALF);
                    const f32x4 v0 = acc[ai][bj][m][0], v1 = acc[ai][bj][m][1];
                    float r[8];
                    r[0] = bflo(g.x) * v0[0]; r[1] = bfhi(g.x) * v0[1]; r[2] = bflo(g.y) * v0[2]; r[3] = bfhi(g.y) * v0[3];
                    r[4] = bflo(g.z) * v1[0]; r[5] = bfhi(g.z) * v1[1]; r[6] = bflo(g.w) * v1[2]; r[7] = bfhi(g.w) * v1[3];
                    if (u.kind != 0 && !MGP) { const u32x4 o = *mp;
                        r[0] += bflo(o.x); r[1] += bfhi(o.x); r[2] += bflo(o.y); r[3] += bfhi(o.y); r[4] += bflo(o.z); r[5] += bfhi(o.z); r[6] += bflo(o.w); r[7] += bfhi(o.w); }
                    u32x4 w; w.x = pk2(r[0], r[1]); w.y = pk2(r[2], r[3]); w.z = pk2(r[4], r[5]); w.w = pk2(r[6], r[7]);
                    *mp = w;
                }
            }
    }
};
}


#define XB_TMO      128
#define XB_XCNT(j)  (256  + 64 * (j))
#define XB_XSUB(j)  (1280 + 64 * (j))
#define XB_XGEN(j)  (2304 + 64 * (j))
#define XB_TOP      3328
#define XB_TOPGEN   3392
#define XCD_BAR_WORDS 3456
#define XB_SPIN_CAP (1u << 18)
__device__ __forceinline__ unsigned xb_ld(unsigned* p)              { return __hip_atomic_load(p, __ATOMIC_RELAXED, __HIP_MEMORY_SCOPE_AGENT); }
__device__ __forceinline__ unsigned xb_add(unsigned* p, unsigned v) { return __hip_atomic_fetch_add(p, v, __ATOMIC_RELAXED, __HIP_MEMORY_SCOPE_AGENT); }
__device__ __forceinline__ unsigned xb_xcc_id() { return (unsigned)__builtin_amdgcn_s_getreg((3 << 11) | 20) & 0xFu; }
#define XB_SPIN(cond, bar) do { unsigned _sp = 0; while (cond) { __builtin_amdgcn_s_sleep(1); \
    if ((++_sp & 255u) == 0u) { if (xb_ld(&(bar)[XB_TMO])) break; if (_sp > XB_SPIN_CAP) { atomicAdd(&(bar)[XB_TMO], 1u); break; } } } } while (0)
struct XcdBarrier { unsigned* bar; unsigned x; volatile LAS unsigned* st; int wv; };
__device__ __forceinline__ XcdBarrier xcd_barrier_post(unsigned* bar, volatile LAS unsigned* st, int wv) {
    XcdBarrier b; b.bar = bar; b.x = xb_xcc_id(); b.st = st; b.wv = wv;
    if (wv == 0 && lane_now() == 0) (void)xb_add(&bar[XB_XCNT(b.x)], 1u);
    return b;
}
__device__ __forceinline__ void xcd_barrier_complete(unsigned* bar, unsigned x, unsigned& nloc, unsigned& nx) {
    const unsigned G = gridDim.x * gridDim.y * gridDim.z;
    unsigned sum, cnt, mine, sp = 0u;
    for (;;) {
        sum = 0u; cnt = 0u; mine = 0u;
#pragma unroll
        for (unsigned j = 0; j < 16; ++j) { const unsigned c = xb_ld(&bar[XB_XCNT(j)]); sum += c; cnt += (c > 0u) ? 1u : 0u; mine = (j == x) ? c : mine; }
        if (sum == G) break;
        __builtin_amdgcn_s_sleep(1);
        if ((++sp & 255u) == 0u) { if (xb_ld(&bar[XB_TMO])) break; if (sp > XB_SPIN_CAP) { atomicAdd(&bar[XB_TMO], 1u); break; } }
    }
    nloc = mine > 0u ? mine : 1u; nx = cnt > 0u ? cnt : 1u;
}
__device__ __forceinline__ void xcd_barrier(const XcdBarrier& b) {
    asm volatile("s_waitcnt vmcnt(0)" ::: "memory");
    __syncthreads();
    if (b.wv == 0 && lane_now() == 0) {
        unsigned* bar = b.bar;
        __builtin_amdgcn_s_waitcnt(0);
        unsigned nloc = b.st[0], nx = b.st[1];
        if (nloc == 0u) { xcd_barrier_complete(bar, b.x, nloc, nx); b.st[0] = nloc; b.st[1] = nx; }
        const unsigned old = xb_add(&bar[XB_XSUB(b.x)], 1u);
        const unsigned gen = old / nloc;
        if (old + 1u == (gen + 1u) * nloc) {
            __builtin_amdgcn_fence(__ATOMIC_RELEASE, "agent");
            asm volatile("s_waitcnt vmcnt(0)" ::: "memory");
            const unsigned og = xb_add(&bar[XB_TOP], 1u);
            const unsigned tg = og / nx;
            if (og + 1u == (tg + 1u) * nx) xb_add(&bar[XB_TOPGEN], 1u);
            else XB_SPIN(xb_ld(&bar[XB_TOPGEN]) == tg, bar);
            __builtin_amdgcn_fence(__ATOMIC_ACQUIRE, "agent");
            xb_add(&bar[XB_XGEN(b.x)], 1u);
            asm volatile("s_waitcnt vmcnt(0)" ::: "memory");
        } else {
            XB_SPIN(xb_ld(&bar[XB_XGEN(b.x)]) == gen, bar);
            __builtin_amdgcn_fence(__ATOMIC_ACQUIRE, "agent");
            asm volatile("s_waitcnt vmcnt(0)" ::: "memory");
        }
    }
    __syncthreads();
}

struct Args {
    const float* x; const float* c; const float* ctx; const float* c_ctx; const float* w_ada; const float* b_ada; const float* g_ffn1; const float* ffn1_w13; const float* ffn1_w2;
    const float* g_mix; const float* w_in; const float* na_bias; const float* wa_sink; const float* w_br; const float* w_out; const float* g_ffn2; const float* ffn2_w13; const float* ffn2_w2; const float* g_final;
    float* out; unsigned char* ws; int ph_lo, ph_hi;
};

struct Ctx { float* out; unsigned char* ws; const float* x; const float* ctx; int wv; };
__device__ __forceinline__ void transpose_item(const float* W, int K, int Nsrc, int src, bf16_t* WT, int nrow0, int kb, LAS float* scr, int lane) {
    const int k0 = 64 * kb;
    if (src >= 0) {
        float t[32];
#pragma unroll
        for (int i = 0; i < 32; ++i) { const int kk = 2 * i + (lane >> 5); t[i] = W[(size_t)(k0 + kk) * Nsrc + src + (lane & 31)]; }
#pragma unroll
        for (int i = 0; i < 32; ++i) { const int kk = 2 * i + (lane >> 5); scr[kk * 33 + (lane & 31)] = t[i]; }
    } else {
#pragma unroll 8
        for (int i = 0; i < 32; ++i) { const int kk = 2 * i + (lane >> 5); scr[kk * 33 + (lane & 31)] = 0.f; }
    }
    asm volatile("s_waitcnt lgkmcnt(0)" ::: "memory");
    const int c = lane & 7;
#pragma unroll
    for (int j = 0; j < 4; ++j) { const int n = (lane >> 3) + 8 * j; const LAS float* s = scr + (8 * c) * 33 + n;
        u32x4 o; o.x = pk2(s[0 * 33], s[1 * 33]); o.y = pk2(s[2 * 33], s[3 * 33]); o.z = pk2(s[4 * 33], s[5 * 33]); o.w = pk2(s[6 * 33], s[7 * 33]);
        *(u32x4*)(WT + (size_t)(nrow0 + n) * K + k0 + 8 * c) = o; }
    asm volatile("s_waitcnt lgkmcnt(0)" ::: "memory");
}

__device__ __forceinline__ void prep_phase(const Args& a, const int wv_, LAS unsigned char* lds, int G) {
    const int lane = lane_now(), wave = wv_, tid = wave * 64 + lane;
    const int gw = blockIdx.x * 8 + wave, NGW = G * 8;
    LAS float* scr = (LAS float*)(lds + wave * 16384);
    LAS float* tab = (LAS float*)(lds + LDS_X);

    if (tid < 64) { float s, c; sincos_turns((double)tid / 64.0, s, c); tab[tid] = c; tab[64 + tid] = s; }
    __syncthreads();
    constexpr int I13 = 176 * 16, I2 = 32 * 44, IIN = 56 * 16, IINT = 24 * 16, IG = 96 * 16, IBR = 3 * 32 * 8, IOUT = 32 * 16;
    constexpr int IL = 2 * I13 + 2 * I2 + IIN + IINT + IG + IBR + IOUT;
    for (int it = gw; it < 2 * IL; it += NGW) {
        const int l = it / IL; int r = it - l * IL;
        unsigned char* wl = a.ws + WS_W + (size_t)l * WS_WL;
        if (r < 2 * I13) { const int which = r / I13; r -= which * I13; const int gi = r >> 4, kb = r & 15; const int pn = gi >> 3, sub = gi & 7;
            const int src = (sub >> 2) * DFF + 128 * pn + 32 * (sub & 3);
            transpose_item((which ? a.ffn2_w13 : a.ffn1_w13) + (size_t)l * DM * 2 * DFF, DM, 2 * DFF, src, (bf16_t*)(wl + (which ? WO_13B : WO_13A)), 32 * gi, kb, scr, lane); continue; }
        r -= 2 * I13;
        if (r < 2 * I2) { const int which = r / I2; r -= which * I2; const int gi = r / 44, kb = r - gi * 44;
            transpose_item((which ? a.ffn2_w2 : a.ffn1_w2) + (size_t)l * DFF * DM, DFF, DM, 32 * gi, (bf16_t*)(wl + (which ? WO_2B : WO_2A)), 32 * gi, kb, scr, lane); continue; }
        r -= 2 * I2;
        const float* win = a.w_in + (size_t)l * DM * PIN;
        if (r < IIN) { const int gi = r >> 4, kb = r & 15; const int pn = gi >> 3, bj = (gi & 7) >> 2, wc = gi & 3, hp = 4 * pn + wc;
            const int src = (hp < 16 ? 64 * hp : 2048 + 64 * (hp - 16)) + 32 * bj;
            transpose_item(win, DM, PIN, src, (bf16_t*)(wl + WO_IN), 32 * gi, kb, scr, lane); continue; }
        r -= IIN;
        if (r < IINT) { const int gi = r >> 4, kb = r & 15; const int src = gi < 16 ? 1024 + 32 * gi : (gi < 20 ? 2688 + 32 * (gi - 16) : -1);
            transpose_item(win, DM, PIN, src, (bf16_t*)(wl + WO_INT), 32 * gi, kb, scr, lane); continue; }
        r -= IINT;
        if (r < IG) { const int gi = r >> 4, kb = r & 15;
            transpose_item(win, DM, PIN, 2816 + 32 * gi, (bf16_t*)(wl + WO_G), 32 * gi, kb, scr, lane); continue; }
        r -= IG;
        if (r < IBR) { const int br = r / 256; r -= br * 256; const int gi = r >> 3, kb = r & 7;
            transpose_item(a.w_br + ((size_t)l * 3 + br) * 512 * DM, 512, DM, 32 * gi, (bf16_t*)(wl + WO_BR), br * 1024 + 32 * gi, kb, scr, lane); continue; }
        r -= IBR;
        { const int gi = r >> 4, kb = r & 15;
          transpose_item(a.w_out + (size_t)l * DM * DM, DM, DM, 32 * gi, (bf16_t*)(wl + WO_OUT), 32 * gi, kb, scr, lane); }
    }
    for (int it = gw; it < 2 * 8 * 128; it += NGW) {
        const int l = it >> 10, grp = (it >> 7) & 7, k0 = (it & 127) * 8;
        const float* win = a.w_in + (size_t)l * DM * PIN + 1536 + grp * 64;
        bf16_t* wt = (bf16_t*)(a.ws + WS_W + (size_t)l * WS_WL + WO_INT);
        float yr[8], yi[8];
#pragma unroll
        for (int kk = 0; kk < 8; ++kk) { yr[kk] = 0.f; yi[kk] = 0.f; }
        for (int c = 0; c < 64; ++c) {
            const int idx = (c * lane) & 63; const float cs = tab[idx], sn = tab[64 + idx];
#pragma unroll
            for (int kk = 0; kk < 8; ++kk) { const float w = win[(size_t)(k0 + kk) * PIN + c]; yr[kk] += w * cs; yi[kk] -= w * sn; }
        }
        u32x4 o; o.x = pk2(yr[0] * 0.125f, yr[1] * 0.125f); o.y = pk2(yr[2] * 0.125f, yr[3] * 0.125f); o.z = pk2(yr[4] * 0.125f, yr[5] * 0.125f); o.w = pk2(yr[6] * 0.125f, yr[7] * 0.125f);
        *(u32x4*)(wt + (size_t)(768 + grp * 64 + lane) * DM + k0) = o;
        o.x = pk2(yi[0] * 0.125f, yi[1] * 0.125f); o.y = pk2(yi[2] * 0.125f, yi[3] * 0.125f); o.z = pk2(yi[4] * 0.125f, yi[5] * 0.125f); o.w = pk2(yi[6] * 0.125f, yi[7] * 0.125f);
        *(u32x4*)(wt + (size_t)(1280 + grp * 64 + lane) * DM + k0) = o;
    }
    {
        const int gt = blockIdx.x * 512 + tid, NT = G * 512;
        float2* rope = (float2*)(a.ws + WS_ROPE);
        for (int e = gt; e < 64 * 16; e += NT) { const int pos = e >> 4, f = e & 15;
            const float c4 = (f & 3) == 0 ? 1.0f : (f & 3) == 1 ? 0.56234132519034908f : (f & 3) == 2 ? 0.31622776601683794f : 0.17782794100389228f;
            const float p10 = (f >> 2) == 0 ? 1.0f : (f >> 2) == 1 ? 0.1f : (f >> 2) == 2 ? 0.01f : 0.001f;
            const float ang = (float)pos * (c4 * p10);
            const double tt = (double)ang * 0.15915494309189533577; const double fr = tt - __builtin_floor(tt);
            float s, c; sincos_turns(fr, s, c); rope[e] = make_float2(c, s); }
        float2* tw = (float2*)(a.ws + WS_TW);
        for (int e = gt; e < 64 * 64; e += NT) { const int n2 = e >> 6, n1p = e & 63; float s, c; sincos_turns((double)(n2 * n1p) / 4096.0, s, c); tw[e] = make_float2(c * (1.f / 64.f), s * (1.f / 64.f)); }
        bf16_t* fb1 = (bf16_t*)(a.ws + WS_FB1);
        for (int e = gt; e < 4 * 8 * 64 * 8; e += NT) { const int j = e & 7, ln = (e >> 3) & 63, nt = (e >> 9) & 7, ks = e >> 12; const int g = ln >> 4;
            const int k = 32 * ks + 8 * g + j, n = 16 * nt + (ln & 15); const int pk = k >> 6, n1 = k & 63, pn = n >> 6, n1p = n & 63;
            const int q = (n1 * n1p) & 63; const float cs = tab[q], sn = tab[64 + q];
            const float v = (pk == pn) ? cs : (pk == 0 ? -sn : sn);
            fb1[e] = (bf16_t)f2bf(v); }
        bf16_t* a3 = (bf16_t*)(a.ws + WS_A3);
        for (int e = gt; e < 4 * 4 * 64 * 8; e += NT) { const int j = e & 7, ln = (e >> 3) & 63, ks3 = (e >> 9) & 3, m3 = e >> 11; const int g = ln >> 4;
            const int n2p = 16 * m3 + (ln & 15); const int mtA = 2 * (ks3 & 1) + (j >> 2); const int n2 = 16 * mtA + 4 * g + (j & 3);
            const int q = (n2 * n2p) & 63; const float v = (ks3 < 2) ? tab[q] : tab[64 + q];
            a3[e] = (bf16_t)f2bf(v); }
    }
    __syncthreads();
    LAS float* sv = (LAS float*)lds;
    LAS float* red = (LAS float*)(lds + 32768);
    for (int e = tid; e < 5 * DM; e += 512) { const int r = e >> 10, k = e & 1023; const float v = r < 4 ? a.c[r * DM + k] : a.c_ctx[k]; sv[e] = v / (1.f + __expf(-v)); }
    __syncthreads();
    float* mod = (float*)(a.ws + WS_MOD);
    for (int it = blockIdx.x; it < 2 * 144; it += G) {
        const int l = it / 144, n0 = (it - l * 144) * 64;
        const float* w = a.w_ada + (size_t)l * DM * NMODC + n0 + lane;
        float ac[5] = {0.f, 0.f, 0.f, 0.f, 0.f};
        const int kbeg = wave * 128;
#pragma unroll 8
        for (int k = kbeg; k < kbeg + 128; ++k) { const float wv = w[(size_t)k * NMODC];
#pragma unroll
            for (int r = 0; r < 5; ++r) ac[r] += sv[r * DM + k] * wv; }
#pragma unroll
        for (int r = 0; r < 5; ++r) red[(wave * 5 + r) * 64 + lane] = ac[r];
        __syncthreads();
        if (tid < 320) { const int r = tid >> 6; float s = 0.f;
#pragma unroll
            for (int wv = 0; wv < 8; ++wv) s += red[(wv * 5 + r) * 64 + lane];
            mod[((size_t)l * 5 + r) * NMODC + n0 + lane] = s + a.b_ada[(size_t)l * NMODC + n0 + lane]; }
        __syncthreads();
    }
    {
        const int gt = blockIdx.x * 512 + tid, NT = G * 512;
        float* sm = (float*)(a.ws + WS_SM);
        for (int e = gt; e < SM_END; e += NT) { float v;
            if (e < SM_GMIX) v = a.g_ffn1[e]; else if (e < SM_GF2) v = a.g_mix[e - SM_GMIX]; else if (e < SM_GFIN) v = a.g_ffn2[e - SM_GF2]; else if (e < SM_SINK) v = a.g_final[e - SM_GFIN];
            else if (e < SM_BIAS) v = (e - SM_SINK) < 16 ? a.wa_sink[e - SM_SINK] : 0.f; else v = a.na_bias[e - SM_BIAS];
            sm[e] = v; }
    }
}

__device__ __forceinline__ bf16_t* h_lat(const Ctx& a) { return (bf16_t*)a.out + (size_t)ML * DM; }
__device__ __forceinline__ f32x4 ld_h4(const bf16_t* p) { const u32x2 w = *(const u32x2*)p; return (f32x4){bflo(w.x), bfhi(w.x), bflo(w.y), bfhi(w.y)}; }
__device__ __forceinline__ void st_h4(bf16_t* p, f32x4 v) { u32x2 w; w.x = pk2(v[0], v[1]); w.y = pk2(v[2], v[3]); *(u32x2*)p = w; }
template <int MODE, int NPARTS = 0>
__device__ __forceinline__ void norm_phase(const Ctx& a, int G, int nrows, const float* gvec, const float* modl, int shidx, const float* pgate = nullptr, float pcoef = 0.f) {
    const int lane = lane_now(), wave = a.wv;
    const int gw = blockIdx.x * 8 + wave, NGW = G * 8;
    bf16_t* HL = h_lat(a); bf16_t* HCx = (bf16_t*)(a.ws + WS_HC); bf16_t* U = (bf16_t*)(a.ws + WS_U);
    const float* part = (const float*)(a.ws + WS_BR);
    for (int row0 = gw * 4; row0 < ML; row0 += NGW * 4) {
        bf16_t* hrow = HL + (size_t)row0 * DM;
        f32x4 v[4][4]; float ss[4];
#pragma unroll
        for (int r = 0; r < 4; ++r) { ss[r] = 0.f;
#pragma unroll
            for (int j = 0; j < 4; ++j) v[r][j] = (MODE == 1) ? *(const f32x4*)(a.x + (size_t)(row0 + r) * DM + 4 * lane + 256 * j) : ld_h4(hrow + (size_t)r * DM + 4 * lane + 256 * j); }
        if (MODE == 1) {
#pragma unroll
            for (int r = 0; r < 4; ++r)
#pragma unroll
                for (int j = 0; j < 4; ++j) { st_h4(hrow + (size_t)r * DM + 4 * lane + 256 * j, v[r][j]); v[r][j] = ld_h4(hrow + (size_t)r * DM + 4 * lane + 256 * j); }
        }
#pragma unroll
        for (int r = 0; r < 4; ++r) {
#pragma unroll
            for (int j = 0; j < 4; ++j) ss[r] += (v[r][j][0] * v[r][j][0] + v[r][j][1] * v[r][j][1]) + (v[r][j][2] * v[r][j][2] + v[r][j][3] * v[r][j][3]);
            ss[r] = 1.0f / sqrtf(wave_sum(ss[r]) * (1.f / DM) + EPS); }
        const int bidx = row0 >> 12;
        const float* sh = modl + (size_t)bidx * NMODC + shidx * DM; const float* sc = sh + DM;
#pragma unroll
        for (int j = 0; j < 4; ++j) { const f32x4 s1 = *(const f32x4*)(sc + 4 * lane + 256 * j), s0 = *(const f32x4*)(sh + 4 * lane + 256 * j), gv = *(const f32x4*)(gvec + 4 * lane + 256 * j);
            const f32x4 mul = gv * (s1 + 1.0f);
#pragma unroll
            for (int r = 0; r < 4; ++r) { const f32x4 o = (v[r][j] * ss[r]) * mul + s0;
                u32x2 w; w.x = pk2(o[0], o[1]); w.y = pk2(o[2], o[3]);
                *(u32x2*)(U + (size_t)(row0 + r) * DM + 4 * lane + 256 * j) = w; } }
    }
    for (int cr = (NGW - 1 - gw); cr < nrows - ML; cr += NGW) {
        bf16_t* hrow = HCx + (size_t)cr * DM;
        f32x4 v[4];
#pragma unroll
        for (int j = 0; j < 4; ++j) v[j] = (MODE == 1) ? *(const f32x4*)(a.ctx + (size_t)cr * DM + 4 * lane + 256 * j) : ld_h4(hrow + 4 * lane + 256 * j);
        if (NPARTS > 0) {
#pragma unroll
            for (int j = 0; j < 4; ++j) { f32x4 pv[NPARTS > 0 ? NPARTS : 1];
#pragma unroll
                for (int ks = 0; ks < NPARTS; ++ks) pv[ks] = *(const f32x4*)(part + ((size_t)ks * MC + cr) * DM + 4 * lane + 256 * j);
                f32x4 sum = pv[0];
#pragma unroll
                for (int ks = 1; ks < NPARTS; ++ks) sum = sum + pv[ks];
                const f32x4 gt = *(const f32x4*)(pgate + 4 * lane + 256 * j) * pcoef;
                v[j] = v[j] + gt * sum; }
        }
        if (MODE == 1 || NPARTS > 0) {
#pragma unroll
            for (int j = 0; j < 4; ++j) { st_h4(hrow + 4 * lane + 256 * j, v[j]); v[j] = ld_h4(hrow + 4 * lane + 256 * j); }
        }
        float ss = 0.f;
#pragma unroll
        for (int j = 0; j < 4; ++j) ss += (v[j][0] * v[j][0] + v[j][1] * v[j][1]) + (v[j][2] * v[j][2] + v[j][3] * v[j][3]);
        ss = 1.0f / sqrtf(wave_sum(ss) * (1.f / DM) + EPS);
        const float* sh = modl + (size_t)4 * NMODC + shidx * DM; const float* sc = sh + DM;
#pragma unroll
        for (int j = 0; j < 4; ++j) { const f32x4 s1 = *(const f32x4*)(sc + 4 * lane + 256 * j), s0 = *(const f32x4*)(sh + 4 * lane + 256 * j), gv = *(const f32x4*)(gvec + 4 * lane + 256 * j);
            const f32x4 o = (v[j] * ss) * (gv * (s1 + 1.0f)) + s0;
            u32x2 w; w.x = pk2(o[0], o[1]); w.y = pk2(o[2], o[3]);
            *(u32x2*)(U + (size_t)(ML + cr) * DM + 4 * lane + 256 * j) = w; }
    }
}
__device__ __forceinline__ void final_phase(const Ctx& a, int G, const float* gvec) {
    const int lane = lane_now(), wave = a.wv;
    const int gw = blockIdx.x * 8 + wave, NGW = G * 8;
    const bf16_t* HF = (const bf16_t*)(a.ws + WS_BR);
    for (int row0 = gw * 4; row0 < ML; row0 += NGW * 4) {
        f32x4 v[4][4]; float ss[4];
#pragma unroll
        for (int r = 0; r < 4; ++r) { ss[r] = 0.f;
#pragma unroll
            for (int j = 0; j < 4; ++j) { v[r][j] = ld_h4(HF + (size_t)(row0 + r) * DM + 4 * lane + 256 * j); ss[r] += (v[r][j][0] * v[r][j][0] + v[r][j][1] * v[r][j][1]) + (v[r][j][2] * v[r][j][2] + v[r][j][3] * v[r][j][3]); } }
#pragma unroll
        for (int r = 0; r < 4; ++r) ss[r] = 1.0f / sqrtf(wave_sum(ss[r]) * (1.f / DM) + EPS);
#pragma unroll
        for (int j = 0; j < 4; ++j) { const f32x4 gv = *(const f32x4*)(gvec + 4 * lane + 256 * j);
#pragma unroll
            for (int r = 0; r < 4; ++r) *(f32x4*)(a.out + (size_t)(row0 + r) * DM + 4 * lane + 256 * j) = v[r][j] * ss[r] * gv; }
    }
}

struct KV { bf16x8 ka0, ka1, kb0, kb1; u32x4 v[4]; };
struct Tile { float m, l; f32x4 o[4]; };
__device__ __forceinline__ void kv_load(KV& kv, const bf16_t* Kb, const bf16_t* Vb, int kt0, int kt1) {
    const bf16_t* K0 = Kb + (size_t)kt0 * PW; const bf16_t* K1 = Kb + (size_t)kt1 * PW;
    kv.ka0 = *(const bf16x8*)K0; kv.ka1 = *(const bf16x8*)(K0 + 32); kv.kb0 = *(const bf16x8*)K1; kv.kb1 = *(const bf16x8*)(K1 + 32);
#pragma unroll
    for (int db = 0; db < 4; ++db) { const u32x2 lo = *(const u32x2*)(Vb + (size_t)kt0 * 64 + db * 64), hi = *(const u32x2*)(Vb + (size_t)kt1 * 64 + db * 64); kv.v[db] = (u32x4){lo.x, lo.y, hi.x, hi.y}; }
}
__device__ __forceinline__ void tile_compute(Tile& st, const LAS bf16x8* qlds, const KV& kv, f32x4 b0, f32x4 b1, const int bp16, const int bp32) {
    const bf16x8 q0 = qlds[0], q1 = qlds[64];
    f32x4 s0 = __builtin_amdgcn_mfma_f32_16x16x32_bf16(kv.ka0, q0, b0, 0, 0, 0);
    s0 = __builtin_amdgcn_mfma_f32_16x16x32_bf16(kv.ka1, q1, s0, 0, 0, 0);
    f32x4 s1 = __builtin_amdgcn_mfma_f32_16x16x32_bf16(kv.kb0, q0, b1, 0, 0, 0);
    s1 = __builtin_amdgcn_mfma_f32_16x16x32_bf16(kv.kb1, q1, s1, 0, 0, 0);
    float mx = fmaxf(fmaxf(fmaxf(s0[0], s0[1]), fmaxf(s0[2], s0[3])), fmaxf(fmaxf(s1[0], s1[1]), fmaxf(s1[2], s1[3])));
    mx = fmaxf(mx, __builtin_bit_cast(float, __builtin_amdgcn_ds_bpermute(bp16, __builtin_bit_cast(int, mx))));
    mx = fmaxf(mx, __builtin_bit_cast(float, __builtin_amdgcn_ds_bpermute(bp32, __builtin_bit_cast(int, mx))));
    if (__builtin_amdgcn_ballot_w64(mx > st.m) != 0ull) {
        const float mn = fmaxf(st.m, mx); const float alpha = __builtin_amdgcn_exp2f(st.m - mn); st.l *= alpha; st.m = mn;
#pragma unroll
        for (int db = 0; db < 4; ++db) st.o[db] = st.o[db] * alpha; }
    const float mn = st.m;
    float p[8];
#pragma unroll
    for (int i = 0; i < 4; ++i) { p[i] = __builtin_amdgcn_exp2f(s0[i] - mn); p[4 + i] = __builtin_amdgcn_exp2f(s1[i] - mn); }
    st.l += ((p[0] + p[1]) + (p[2] + p[3])) + ((p[4] + p[5]) + (p[6] + p[7]));
    u32x4 pw; pw.x = pk2(p[0], p[1]); pw.y = pk2(p[2], p[3]); pw.z = pk2(p[4], p[5]); pw.w = pk2(p[6], p[7]);
    const bf16x8 pb = __builtin_bit_cast(bf16x8, pw);
#pragma unroll
    for (int db = 0; db < 4; ++db) st.o[db] = __builtin_amdgcn_mfma_f32_16x16x32_bf16(__builtin_bit_cast(bf16x8, kv.v[db]), pb, st.o[db], 0, 0, 0);
    __builtin_amdgcn_sched_barrier(0);
}

__device__ __forceinline__ void pair_compute(Tile (&T)[4], const LAS bf16x8* qlds, const KV& cur, const LAS float* btab, const int p, const int kind, const int h, const int r0, const int krlo,
                                             const int bs, const int qc, const int wsx, const int qt, const int qpos, const int g, const int bp16, const int bp32) {
    const f32x4 zero4 = (f32x4){0.f, 0.f, 0.f, 0.f};
    f32x4 bc0 = zero4, bc1 = zero4; bool anyv = true;
    int dca[4], dcb[4]; bool vla[4], vlb[4];
    const int kr = krlo + p - 8;
    const bool loc = p >= 8;
    if (loc) {
        if (kind == 0) {
#pragma unroll
            for (int i = 0; i < 4; ++i) { const int kca = bs + 4 * g + i, kcb = kca + 16;
                dca[i] = min(max(kca - qc, -15), 15) + 15; dcb[i] = min(max(kcb - qc, -15), 15) + 15;
                vla[i] = (kca >= wsx && kca < wsx + 16); vlb[i] = (kcb >= wsx && kcb < wsx + 16); }
        } else {
            const int kp0 = qt * 16 - 128 + 32 * (p - 8), kp1 = kp0 + 16;
            const bool v0 = kp0 >= 0 && kp0 < SEQ, v1 = (p - 8 < 8) && kp1 >= 0 && kp1 < SEQ;
#pragma unroll
            for (int i = 0; i < 4; ++i) { const int da = kp0 + 4 * g + i - qpos, db2 = kp1 + 4 * g + i - qpos;
                bc0[i] = (v0 && da >= -128 && da <= 128) ? 0.f : -1e30f; bc1[i] = (v1 && db2 >= -128 && db2 <= 128) ? 0.f : -1e30f; }
            anyv = v0 || v1;
        }
    }
    const bool na_loc = (kind == 0) && loc;
#pragma unroll
    for (int j = 0; j < 4; ++j) {
        bool act = anyv; f32x4 b0 = bc0, b1 = bc1;
        if (na_loc) { const int rj = r0 + j; const int rsj = min(max(rj - 4, 0), 56); act = (kr >= rsj && kr <= rsj + 7);
            if (act) { const LAS float* brow = btab + h * 465 + (kr - rj + 7) * 31;
#pragma unroll
                for (int i = 0; i < 4; ++i) { b0[i] = vla[i] ? brow[dca[i]] : -1e30f; b1[i] = vlb[i] ? brow[dcb[i]] : -1e30f; } } }
        if (act) tile_compute(T[j], qlds + j * 128, cur, b0, b1, bp16, bp32);
    }
}

__device__ __forceinline__ void attn_multi(const Ctx& a, LAS unsigned char* lds, const LAS float* btab, int layer, int kind, int id) {
    const int lane = lane_now(), fr = lane & 15, g = lane >> 4;
    const bf16_t* P = (const bf16_t*)(a.ws + WS_R1); const bf16_t* VT = (const bf16_t*)(a.ws + WS_VT); bf16_t* BR = (bf16_t*)(a.ws + WS_BR);
    const float* sinks = (const float*)(a.ws + WS_SM) + SM_SINK + layer * 8;
    int b, h = 0, q0b, q0s, qcb, qcs, kcol, vrow; bool has_sink = false;
    int r0 = 0, cb = 0, qt = 0, kvh = 0, np = 8;
    if (kind == 0) { cb = id & 3; r0 = ((id >> 2) & 15) * 4; h = (id >> 6) & 7; b = id >> 9; q0b = b * SEQ + r0 * 64 + cb * 16; q0s = 64; qcb = h * 64; qcs = 0; kcol = 512 + h * 64; vrow = h * 64; }
    else if (kind == 1) { qt = id & 255; kvh = (id >> 8) & 1; b = id >> 9; q0b = b * SEQ + qt * 16; q0s = 0; qcb = 1024 + kvh * 256; qcs = 64; kcol = 1536 + kvh * 64; vrow = 512 + kvh * 64; has_sink = true; np = 17; }
    else if (kind == 2) { const int qq = id & 3; h = (id >> 2) & 7; b = id >> 5; q0b = ML + b * CTXL + qq * 64; q0s = 16; qcb = h * 64; qcs = 0; kcol = 512 + h * 64; vrow = h * 64; }
    else { qt = id & 15; kvh = (id >> 4) & 1; b = id >> 5; q0b = ML + b * CTXL + qt * 16; q0s = 0; qcb = 1024 + kvh * 256; qcs = 64; kcol = 1536 + kvh * 64; vrow = 512 + kvh * 64; has_sink = true; }
    Tile T[4];
    LAS bf16x8* qlds = (LAS bf16x8*)(lds + a.wv * 8192) + lane;
#pragma unroll
    for (int j = 0; j < 4; ++j) { const bf16_t* qp = P + (size_t)(q0b + j * q0s + fr) * PW + qcb + j * qcs + 8 * g; { const u32x4 qa = *(const u32x4*)qp, qb = *(const u32x4*)(qp + 32); u32x4 sa, sb;
          sa.x = pk2(bflo(qa.x) * 0.18033688011112042f, bfhi(qa.x) * 0.18033688011112042f); sa.y = pk2(bflo(qa.y) * 0.18033688011112042f, bfhi(qa.y) * 0.18033688011112042f); sa.z = pk2(bflo(qa.z) * 0.18033688011112042f, bfhi(qa.z) * 0.18033688011112042f); sa.w = pk2(bflo(qa.w) * 0.18033688011112042f, bfhi(qa.w) * 0.18033688011112042f);
          sb.x = pk2(bflo(qb.x) * 0.18033688011112042f, bfhi(qb.x) * 0.18033688011112042f); sb.y = pk2(bflo(qb.y) * 0.18033688011112042f, bfhi(qb.y) * 0.18033688011112042f); sb.z = pk2(bflo(qb.z) * 0.18033688011112042f, bfhi(qb.z) * 0.18033688011112042f); sb.w = pk2(bflo(qb.w) * 0.18033688011112042f, bfhi(qb.w) * 0.18033688011112042f);
          qlds[j * 128] = __builtin_bit_cast(bf16x8, sa); qlds[j * 128 + 64] = __builtin_bit_cast(bf16x8, sb); }
        T[j].m = -1e30f; T[j].l = 0.f;
#pragma unroll
        for (int db = 0; db < 4; ++db) T[j].o[db] = (f32x4){0.f, 0.f, 0.f, 0.f}; }
    const bf16_t* Kb = P + (size_t)fr * PW + kcol + 8 * g;
    const bf16_t* Vb = VT + (size_t)(vrow >> 6) * ((size_t)MT * 64) + fr * 4 + g * 256;
    const int kc0 = ML + b * CTXL;
    const int krlo = min(max(r0 - 4, 0), 56), krhi = min(max(r0 + 3 - 4, 0), 56) + 7;
    const int bs = min(max(cb * 16 - 8, 0), 32); const int qc = cb * 16 + fr; const int wsx = min(max(qc - 8, 0), 48);
    if (kind == 0) np = 8 + (krhi - krlo + 1);
    const int qpos = qt * 16 + fr;
    const f32x4 zero4 = (f32x4){0.f, 0.f, 0.f, 0.f};
#define PAIR_KT(pp, kt0, kt1) do { if ((pp) < 8) { kt0 = kc0 + 32 * (pp); kt1 = kt0 + 16; } \
        else if (kind == 0) { kt0 = b * SEQ + (krlo + (pp) - 8) * 64 + bs; kt1 = kt0 + 16; } \
        else { const int kp0_ = qt * 16 - 128 + 32 * ((pp) - 8); kt0 = b * SEQ + min(max(kp0_, 0), SEQ - 16); kt1 = b * SEQ + min(max(kp0_ + 16, 0), SEQ - 16); } } while (0)
    const int bp16 = (lane ^ 16) * 4, bp32 = (lane ^ 32) * 4;
    KV ka, kb;
    kv_load(ka, Kb, Vb, kc0, kc0 + 16);
#pragma unroll 1
    for (int p = 0; p < np; p += 2) {
        if (p + 1 < np) { int kt0, kt1; PAIR_KT(p + 1, kt0, kt1); kv_load(kb, Kb, Vb, kt0, kt1); }
        pair_compute(T, qlds, ka, btab, p, kind, h, r0, krlo, bs, qc, wsx, qt, qpos, g, bp16, bp32);
        if (p + 1 < np) {
            if (p + 2 < np) { int kt0, kt1; PAIR_KT(p + 2, kt0, kt1); kv_load(ka, Kb, Vb, kt0, kt1); }
            pair_compute(T, qlds, kb, btab, p + 1, kind, h, r0, krlo, bs, qc, wsx, qt, qpos, g, bp16, bp32);
        }
    }
#undef PAIR_KT
#pragma unroll
    for (int j = 0; j < 4; ++j) {
        float lt = T[j].l; lt += __shfl_xor(lt, 16); lt += __shfl_xor(lt, 32);
        if (has_sink) lt += __builtin_amdgcn_exp2f(sinks[4 * kvh + j] * 1.4426950408889634f - T[j].m);
        const float inv = 1.0f / lt;
        bf16_t* op = BR + (size_t)(q0b + j * q0s + fr) * BRW + qcb + j * qcs + 4 * g;
#pragma unroll
        for (int db = 0; db < 4; ++db) { const f32x4 o = T[j].o[db] * inv; u32x2 w; w.x = pk2(o[0], o[1]); w.y = pk2(o[2], o[3]); *(u32x2*)(op + db * 16) = w; }
    }
}

__device__ __forceinline__ void fourier_unit(const Ctx& a, LAS unsigned char* lds, int unit) {
    const int lane = lane_now(), wave = a.wv, tid = wave * 64 + lane, fr = lane & 15, g = lane >> 4;
    const int b = unit >> 6, cg8 = unit & 63; const int cY = cg8 * 8 + wave;
    const bf16_t* YT = (const bf16_t*)(a.ws + WS_VT); bf16_t* BR = (bf16_t*)(a.ws + WS_BR);
    const bf16x8* FB1 = (const bf16x8*)(a.ws + WS_FB1); const bf16x8* A3 = (const bf16x8*)(a.ws + WS_A3); const float2* TW = (const float2*)(a.ws + WS_TW);
    LAS bf16_t* inp = (LAS bf16_t*)(lds + wave * 16384);
    LAS bf16_t* stg = (LAS bf16_t*)(lds + LDS_X + 15360);
    {
        const u32x4* s0 = (const u32x4*)(YT + (size_t)(768 + cY) * MT + (size_t)b * SEQ) + lane;
        const u32x4* s1 = (const u32x4*)(YT + (size_t)(1280 + cY) * MT + (size_t)b * SEQ) + lane;
        u32x4 v[8];
#pragma unroll
        for (int i = 0; i < 8; ++i) v[i] = s0[i * 64];
#pragma unroll
        for (int i = 0; i < 8; ++i) *(LAS u32x4*)(inp + (i * 64 + lane) * 8) = v[i];
#pragma unroll
        for (int i = 0; i < 8; ++i) v[i] = s1[i * 64];
#pragma unroll
        for (int i = 0; i < 8; ++i) *(LAS u32x4*)(inp + 4096 + (i * 64 + lane) * 8) = v[i];
    }
#pragma unroll 1
    for (int nt3 = 0; nt3 < 4; ++nt3) {
        bf16x8 fb[4][2];
#pragma unroll
        for (int ks = 0; ks < 4; ++ks) { fb[ks][0] = FB1[(ks * 8 + nt3) * 64 + lane]; fb[ks][1] = FB1[(ks * 8 + nt3 + 4) * 64 + lane]; }
        const bf16x8* A3p = A3; asm volatile("" : "+v"(A3p));
        bf16x8 a3[4][4];
#pragma unroll
        for (int m3 = 0; m3 < 4; ++m3)
#pragma unroll
            for (int ks3 = 0; ks3 < 4; ++ks3) a3[m3][ks3] = A3p[(m3 * 4 + ks3) * 64 + lane];
        f32x4 zr[4], zi[4];
#pragma unroll
        for (int mt = 0; mt < 4; ++mt) {
            zr[mt] = (f32x4){0.f, 0.f, 0.f, 0.f}; zi[mt] = (f32x4){0.f, 0.f, 0.f, 0.f};
#pragma unroll
            for (int ks = 0; ks < 4; ++ks) {
                const LAS bf16_t* src = inp + (ks >> 1) * 4096 + (32 * (ks & 1) + 8 * g) * 64 + 16 * mt + fr;
                bf16x8 A1;
#pragma unroll
                for (int j = 0; j < 8; ++j) A1[j] = (short)src[j * 64];
                zr[mt] = __builtin_amdgcn_mfma_f32_16x16x32_bf16(A1, fb[ks][0], zr[mt], 0, 0, 0);
                zi[mt] = __builtin_amdgcn_mfma_f32_16x16x32_bf16(A1, fb[ks][1], zi[mt], 0, 0, 0);
            }
        }
#pragma unroll
        for (int mt = 0; mt < 4; ++mt)
#pragma unroll
            for (int i = 0; i < 4; ++i) { const float2 cs = TW[(16 * mt + 4 * g + i) * 64 + 16 * nt3 + fr];
                const float r_ = zr[mt][i], i_ = zi[mt][i]; zr[mt][i] = r_ * cs.x + i_ * cs.y; zi[mt][i] = i_ * cs.x - r_ * cs.y; }
        bf16x8 B3[4];
        { u32x4 w;
          w.x = pk2(zr[0][0], zr[0][1]); w.y = pk2(zr[0][2], zr[0][3]); w.z = pk2(zr[1][0], zr[1][1]); w.w = pk2(zr[1][2], zr[1][3]); B3[0] = __builtin_bit_cast(bf16x8, w);
          w.x = pk2(zr[2][0], zr[2][1]); w.y = pk2(zr[2][2], zr[2][3]); w.z = pk2(zr[3][0], zr[3][1]); w.w = pk2(zr[3][2], zr[3][3]); B3[1] = __builtin_bit_cast(bf16x8, w);
          w.x = pk2(zi[0][0], zi[0][1]); w.y = pk2(zi[0][2], zi[0][3]); w.z = pk2(zi[1][0], zi[1][1]); w.w = pk2(zi[1][2], zi[1][3]); B3[2] = __builtin_bit_cast(bf16x8, w);
          w.x = pk2(zi[2][0], zi[2][1]); w.y = pk2(zi[2][2], zi[2][3]); w.z = pk2(zi[3][0], zi[3][1]); w.w = pk2(zi[3][2], zi[3][3]); B3[3] = __builtin_bit_cast(bf16x8, w); }
#pragma unroll
        for (int m3 = 0; m3 < 4; ++m3) {
            f32x4 o = (f32x4){0.f, 0.f, 0.f, 0.f};
#pragma unroll
            for (int ks3 = 0; ks3 < 4; ++ks3) o = __builtin_amdgcn_mfma_f32_16x16x32_bf16(a3[m3][ks3], B3[ks3], o, 0, 0, 0);
#pragma unroll
            for (int i = 0; i < 4; ++i) { const int n2p = 16 * m3 + 4 * g + i; stg[(n2p * 16 + fr) * 8 + wave] = (bf16_t)f2bf(o[i]); }
        }
        __syncthreads();
        for (int e = tid; e < 1024; e += 512) { const int n2p = e >> 4, f = e & 15; const int tok = 16 * nt3 + f + 64 * n2p;
            const u32x4 v = *(const LAS u32x4*)(stg + e * 8); *(u32x4*)(BR + (size_t)(b * SEQ + tok) * BRW + 512 + cg8 * 8) = v; }
        __syncthreads();
    }
}

__device__ __forceinline__ void mix_phase(const Ctx& a, LAS unsigned char* lds, int G, int layer) {
    const int lane = lane_now(), wave = a.wv, tid = wave * 64 + lane;
    const int gw = blockIdx.x * 8 + wave, NGW = G * 8;
    LAS float* btab = (LAS float*)(lds + LDS_X);
    { const float* src = (const float*)(a.ws + WS_SM) + SM_BIAS + layer * 3720; for (int e = tid; e < 3720; e += 512) btab[e] = src[e] * 1.4426950408889634f; }
    for (int u = blockIdx.x; u < 256; u += G) fourier_unit(a, lds, u);
    LAS float* t256 = (LAS float*)(lds + 65536);
    if (layer == 0) { if (tid < 256) { float s, c; sincos_turns((double)tid / 256.0, s, c); t256[tid] = c; t256[256 + tid] = s; } }
    __syncthreads();
    const int n_c = (layer == 0) ? 128 : 0;
    const int total = 4096 + 2 * n_c;
    for (int id = gw; id < total; id += NGW) {
        int kind, uid;
        if (id < 2048) { kind = 0; uid = id; } else if (id < 4096) { kind = 1; uid = id - 2048; } else if (id < 4096 + n_c) { kind = 2; uid = id - 4096; } else { kind = 3; uid = id - 4096 - n_c; }
        attn_multi(a, lds, btab, layer, kind, uid);
    }
    if (layer == 0) {
        const bf16_t* YT = (const bf16_t*)(a.ws + WS_VT); bf16_t* BR = (bf16_t*)(a.ws + WS_BR);
        for (int it = gw; it < 4 * 512 * 4; it += NGW) {
            const int q = it & 3, cp = (it >> 2) & 511, b = it >> 11; const int np = 64 * q + lane;
            const u32x4* yr = (const u32x4*)(YT + (size_t)(768 + cp) * MT + ML + b * CTXL); const u32x4* yi = (const u32x4*)(YT + (size_t)(1280 + cp) * MT + ML + b * CTXL);
            float acc = 0.f;
#pragma unroll 2
            for (int n8 = 0; n8 < 32; ++n8) { const u32x4 r = yr[n8], im = yi[n8];
                const unsigned rw[4] = {r.x, r.y, r.z, r.w}, iw[4] = {im.x, im.y, im.z, im.w};
#pragma unroll
                for (int e = 0; e < 4; ++e) { const int n = 8 * n8 + 2 * e; const int i0 = (n * np) & 255, i1 = ((n + 1) * np) & 255;
                    acc += t256[i0] * bflo(rw[e]) + t256[256 + i0] * bflo(iw[e]); acc += t256[i1] * bfhi(rw[e]) + t256[256 + i1] * bfhi(iw[e]); } }
            BR[(size_t)(ML + b * CTXL + np) * BRW + 512 + cp] = (bf16_t)f2bf(acc * (1.f / 16.f));
        }
    }
}

constexpr int N_PHASES = 26;
template <int L>
__device__ __forceinline__ void layer_phases(const Ctx& cx, const XcdBarrier& xb, LAS unsigned char* lds, const int G, const int c, const int lo, const int hi) {
    unsigned char* ws = cx.ws;
    bf16_t* HL = h_lat(cx); bf16_t* HCx = (bf16_t*)(ws + WS_HC);
    const float* mod = (const float*)(ws + WS_MOD);
    const float* sm = (const float*)(ws + WS_SM);
    constexpr bool last = (L == 1);
    const unsigned char* wl = ws + WS_W + (size_t)L * WS_WL;
    const float* modl = mod + (size_t)L * 5 * NMODC;
    constexpr int Mfull = MT, Mlat = last ? ML : MT;
    constexpr int P0 = 1 + 12 * L;
#define IN(k) (lo <= (k) && (k) < hi)
#define SEAM(k) do { if (IN(k) && IN((k) + 1)) xcd_barrier(xb); } while (0)
    if (IN(P0 + 0)) { if (L == 0) norm_phase<1>(cx, G, MT, sm + SM_GF1 + L * DM, modl, 0); else norm_phase<0, 11>(cx, G, MT, sm + SM_GF1 + L * DM, modl, 0, mod + 4 * NMODC + 8 * DM, 0.5f); }
    SEAM(P0 + 0);
    if (IN(P0 + 1)) {
        pg8::Sched2 S{}; S.G = G; S.c = c; S.nM0 = Mfull / 256; S.nN0 = 22; S.n0 = S.nM0 * S.nN0; S.A0 = (const char*)(ws + WS_U); S.B0 = (const char*)(wl + WO_13A);
        S.at0 = (size_t)256 * DM * 2; S.bt0 = (size_t)256 * DM * 2; S.n1 = 0;
        pg8::EpiUp E{(bf16_t*)(ws + WS_R1)};
        if ((NULLMASK >> (P0 + 1)) & 1u) { pg8::EpiNullP E0{(float*)(ws + 32768)}; pg8::gemm_phase(cx.wv, lds, DM, DM, DM, S, E0); }
        pg8::gemm_phase(cx.wv, lds, DM, DM, DM, S, E); if ((REPMASK >> (P0 + 1)) & 1u) { xcd_barrier(xb); pg8::gemm_phase(cx.wv, lds, DM, DM, DM, S, E); } }
    SEAM(P0 + 1);
    if (IN(P0 + 2)) {
        { pg8::Sched2 S{}; S.G = G; S.c = c; S.nM0 = ML / 256; S.nN0 = 4; S.n0 = S.nM0 * S.nN0; S.A0 = (const char*)(ws + WS_R1); S.B0 = (const char*)(wl + WO_2A);
          S.at0 = (size_t)256 * DFF * 2; S.bt0 = (size_t)256 * DFF * 2; S.n1 = 0;
          pg8::EpiRes E{HL, HCx, modl + 2 * DM, 0.5f, HL};
          if ((NULLMASK >> (P0 + 2)) & 1u) { pg8::EpiNull E0{(float*)(ws + 32768)}; pg8::gemm_phase(cx.wv, lds, DFF, DFF, DFF, S, E0); }
          pg8::gemm_phase(cx.wv, lds, DFF, DFF, DFF, S, E); }
        { pg8::SchedSplit S{G, c, 11, (const char*)(ws + WS_R1) + (size_t)ML * DFF * 2, (const char*)(wl + WO_2A), (size_t)DFF * 2, (size_t)DFF * 2, 11, 0};
          pg8::EpiPart E{(float*)(ws + WS_BR)};
          pg8::gemm_phase(cx.wv, lds, 256, DFF, DFF, S, E); } }
    SEAM(P0 + 2);
    if (IN(P0 + 3)) norm_phase<0, 11>(cx, G, MT, sm + SM_GMIX + L * DM, modl, 3, modl + 4 * NMODC + 2 * DM, 0.5f);
    SEAM(P0 + 3);
    if (IN(P0 + 4)) {
        pg8::Sched2 S{}; S.G = G; S.c = c;
        S.nM0 = MT / 256; S.nN0 = 7; S.n0 = S.nM0 * S.nN0; S.A0 = (const char*)(ws + WS_U); S.B0 = (const char*)(wl + WO_IN); S.at0 = (size_t)256 * DM * 2; S.bt0 = (size_t)256 * DM * 2;
        S.nM1 = 7; S.nN1 = MT / 256; S.n1 = S.nM1 * S.nN1; S.A1 = (const char*)(wl + WO_INT); S.B1 = (const char*)(ws + WS_U); S.at1 = (size_t)256 * DM * 2; S.bt1 = (size_t)256 * DM * 2;
        pg8::EpiWin E{(bf16_t*)(ws + WS_R1), (bf16_t*)(ws + WS_VT), (const float*)(ws + WS_ROPE)};
        pg8::gemm_phase(cx.wv, lds, DM, DM, DM, S, E); if ((REPMASK >> (P0 + 4)) & 1u) { xcd_barrier(xb); pg8::gemm_phase(cx.wv, lds, DM, DM, DM, S, E); } }
    SEAM(P0 + 4);
    if (IN(P0 + 5)) { mix_phase(cx, lds, G, L); if ((REPMASK >> (P0 + 5)) & 1u) { xcd_barrier(xb); mix_phase(cx, lds, G, L); } }
    SEAM(P0 + 5);
    if (IN(P0 + 6)) {
        pg8::Sched2 S{}; S.G = G; S.c = c; S.nM0 = Mlat / 256; S.nN0 = 12; S.n0 = S.nM0 * S.nN0; S.A0 = (const char*)(ws + WS_U); S.B0 = (const char*)(wl + WO_G);
        S.at0 = (size_t)256 * DM * 2; S.bt0 = (size_t)256 * DM * 2; S.n1 = 0;
        pg8::EpiGate E{(bf16_t*)(ws + WS_R1)};
        pg8::gemm_phase(cx.wv, lds, DM, DM, DM, S, E); if ((REPMASK >> (P0 + 6)) & 1u) { xcd_barrier(xb); pg8::gemm_phase(cx.wv, lds, DM, DM, DM, S, E); } }
    SEAM(P0 + 6);
    if (IN(P0 + 7)) {
        { pg8::SchedMerge S{G, c, ML / 256, (const char*)(ws + WS_BR), (const char*)(wl + WO_BR)};
          pg8::EpiMerge E{(const bf16_t*)(ws + WS_R1), (bf16_t*)(ws + WS_U), nullptr};
          pg8::gemm_phase(cx.wv, lds, 512, BRW, 512, S, E); }
        if (!last) { pg8::SchedMergeCtx S{G, c, (const char*)(ws + WS_BR), (const char*)(wl + WO_BR)};
          pg8::EpiMerge E{(const bf16_t*)(ws + WS_R1), (bf16_t*)(ws + WS_U), (bf16_t*)cx.out};
          pg8::gemm_phase(cx.wv, lds, 512, BRW, 512, S, E); } }
    SEAM(P0 + 7);
    if (IN(P0 + 8)) {
        { pg8::Sched2 S{}; S.G = G; S.c = c; S.nM0 = ML / 256; S.nN0 = 4; S.n0 = S.nM0 * S.nN0; S.A0 = (const char*)(ws + WS_U); S.B0 = (const char*)(wl + WO_OUT);
          S.at0 = (size_t)256 * DM * 2; S.bt0 = (size_t)256 * DM * 2; S.n1 = 0;
          pg8::EpiRes E{HL, HCx, modl + 5 * DM, 1.0f, HL};
          pg8::gemm_phase(cx.wv, lds, DM, DM, DM, S, E); }
        if (!last) { pg8::SchedSplit S{G, c, 12, (const char*)cx.out, (const char*)(wl + WO_OUT), (size_t)DM * 2, (size_t)DM * 2, 4, (size_t)MC * DM * 2};
          pg8::EpiPart E{(float*)(ws + WS_BR)};
          pg8::gemm_phase(cx.wv, lds, 256, DM, DM, S, E); } }
    SEAM(P0 + 8);
    if (IN(P0 + 9)) { if (last) norm_phase<0>(cx, G, Mlat, sm + SM_GF2 + L * DM, modl, 6); else norm_phase<0, 12>(cx, G, Mlat, sm + SM_GF2 + L * DM, modl, 6, modl + 4 * NMODC + 5 * DM, 1.0f); }
    SEAM(P0 + 9);
    if (IN(P0 + 10)) {
        pg8::Sched2 S{}; S.G = G; S.c = c; S.nM0 = Mlat / 256; S.nN0 = 22; S.n0 = S.nM0 * S.nN0; S.A0 = (const char*)(ws + WS_U); S.B0 = (const char*)(wl + WO_13B);
        S.at0 = (size_t)256 * DM * 2; S.bt0 = (size_t)256 * DM * 2; S.n1 = 0;
        pg8::EpiUp E{(bf16_t*)(ws + WS_R1)};
        pg8::gemm_phase(cx.wv, lds, DM, DM, DM, S, E); if ((REPMASK >> (P0 + 10)) & 1u) { xcd_barrier(xb); pg8::gemm_phase(cx.wv, lds, DM, DM, DM, S, E); } }
    SEAM(P0 + 10);
    if (IN(P0 + 11)) {
        { pg8::Sched2 S{}; S.G = G; S.c = c; S.nM0 = ML / 256; S.nN0 = 4; S.n0 = S.nM0 * S.nN0; S.A0 = (const char*)(ws + WS_R1); S.B0 = (const char*)(wl + WO_2B);
          S.at0 = (size_t)256 * DFF * 2; S.bt0 = (size_t)256 * DFF * 2; S.n1 = 0;
          pg8::EpiRes E{HL, HCx, modl + 8 * DM, 0.5f, last ? (bf16_t*)(ws + WS_BR) : HL};
          if ((NULLMASK >> (P0 + 11)) & 1u) { pg8::EpiNull E0{(float*)(ws + 32768)}; pg8::gemm_phase(cx.wv, lds, DFF, DFF, DFF, S, E0); }
          pg8::gemm_phase(cx.wv, lds, DFF, DFF, DFF, S, E); }
        if (!last) { pg8::SchedSplit S{G, c, 11, (const char*)(ws + WS_R1) + (size_t)ML * DFF * 2, (const char*)(wl + WO_2B), (size_t)DFF * 2, (size_t)DFF * 2, 11, 0};
          pg8::EpiPart E{(float*)(ws + WS_BR)};
          pg8::gemm_phase(cx.wv, lds, 256, DFF, DFF, S, E); } }
    SEAM(P0 + 11);
#undef IN
#undef SEAM
}

__global__ void __launch_bounds__(512, 2) mk_fwd(Args a) {
    extern __shared__ __attribute__((aligned(16))) unsigned char lds_raw[];
    LAS unsigned char* lds = (LAS unsigned char*)lds_raw;
    const int G = gridDim.x, c = blockIdx.x;
    const int lo = a.ph_lo, hi = a.ph_hi;
    volatile LAS unsigned* xst = (volatile LAS unsigned*)(lds + LDS_BYTES - 64);
    const int wv = __builtin_amdgcn_readfirstlane((int)(threadIdx.x >> 6));
    { const int l0 = lane_now(); if (wv == 0 && l0 < 2) xst[l0] = 0u; }
    __syncthreads();
    XcdBarrier xb = xcd_barrier_post((unsigned*)a.ws, xst, wv);
    if (hi > 0x7fff0000) cg::this_grid().sync();
    if (lo == 0) { prep_phase(a, wv, lds, G); if (REPMASK & 1u) { xcd_barrier(xb); prep_phase(a, wv, lds, G); } if (hi > 1) xcd_barrier(xb); }
    Ctx cx; cx.out = a.out; cx.ws = a.ws; cx.x = a.x; cx.ctx = a.ctx; cx.wv = wv;
    layer_phases<0>(cx, xb, lds, G, c, lo, hi);
    layer_phases<1>(cx, xb, lds, G, c, lo, hi);
    if (hi == N_PHASES) final_phase(cx, G, (const float*)(cx.ws + WS_SM) + SM_GFIN);
}

extern "C" void kernel_launch(void* const* d_in, const int* in_sizes, int n_in, void* d_out, int out_size, void* d_ws, size_t ws_size, hipStream_t stream) {
    static int grid = 0;
    if (grid == 0) {
        if (n_in != 19 || out_size != ML * DM || ws_size < WS_END) { fprintf(stderr, "kernel_launch: unexpected shapes: n_in %d out %d ws %zu (need %zu)\n", n_in, out_size, ws_size, (size_t)WS_END); grid = -1; return; }
        int dev = 0, cus = 0, per_cu = 0;
        (void)hipGetDevice(&dev); (void)hipDeviceGetAttribute(&cus, hipDeviceAttributeMultiprocessorCount, dev);
        if (hipFuncSetAttribute((const void*)mk_fwd, hipFuncAttributeMaxDynamicSharedMemorySize, LDS_BYTES) != hipSuccess) { fprintf(stderr, "kernel_launch: hipFuncSetAttribute failed\n"); grid = -1; return; }
        if (hipOccupancyMaxActiveBlocksPerMultiprocessor(&per_cu, (const void*)mk_fwd, 512, LDS_BYTES) != hipSuccess || per_cu < 1) { fprintf(stderr, "kernel_launch: occupancy query says %d\n", per_cu); per_cu = 1; }
        (void)hipGetLastError();
        grid = cus * per_cu;
        fprintf(stderr, "kernel_launch: grid %d (cus %d per_cu %d) ws %zu\n", grid, cus, per_cu, ws_size);
    }
    if (grid < 0) return;
    Args a{};
    a.x = (const float*)d_in[0]; a.c = (const float*)d_in[1]; a.ctx = (const float*)d_in[2]; a.c_ctx = (const float*)d_in[3]; a.w_ada = (const float*)d_in[4]; a.b_ada = (const float*)d_in[5];
    a.g_ffn1 = (const float*)d_in[6]; a.ffn1_w13 = (const float*)d_in[7]; a.ffn1_w2 = (const float*)d_in[8]; a.g_mix = (const float*)d_in[9]; a.w_in = (const float*)d_in[10];
    a.na_bias = (const float*)d_in[11]; a.wa_sink = (const float*)d_in[12]; a.w_br = (const float*)d_in[13]; a.w_out = (const float*)d_in[14]; a.g_ffn2 = (const float*)d_in[15];
    a.ffn2_w13 = (const float*)d_in[16]; a.ffn2_w2 = (const float*)d_in[17]; a.g_final = (const float*)d_in[18];
    a.out = (float*)d_out; a.ws = (unsigned char*)d_ws;
    (void)hipMemsetAsync(d_ws, 0, 16384, stream);
#if MK_MULTI
    for (int ph = 0; ph < N_PHASES; ++ph) { a.ph_lo = ph; a.ph_hi = ph + 1; hipLaunchKernelGGL(mk_fwd, dim3(grid), dim3(512), LDS_BYTES, stream, a); }
#else
    a.ph_lo = 0; a.ph_hi = N_PHASES;
    void* args[] = {&a};
    hipError_t e = hipLaunchCooperativeKernel((const void*)mk_fwd, dim3(grid), dim3(512), args, LDS_BYTES, stream);
    if (e != hipSuccess) fprintf(stderr, "cooperative launch failed: %s (grid %d)\n", hipGetErrorString(e), grid);
#endif
}
```

```cpp
#include <hip/hip_runtime.h>
#include <hip/hip_cooperative_groups.h>
#include <cstdio>
#include <cstdint>
namespace cg = cooperative_groups;

#ifndef MK_MULTI
#define MK_MULTI 0
#endif

#ifndef NULLMASK
#define NULLMASK 0u
#endif
#ifndef REPMASK
#define REPMASK 0u
#endif
#define LAS __attribute__((address_space(3)))
typedef unsigned short bf16_t;
typedef short bf16x8 __attribute__((ext_vector_type(8)));
typedef short s16x4 __attribute__((ext_vector_type(4)));
typedef float f32x4 __attribute__((ext_vector_type(4)));
typedef float f32x2 __attribute__((ext_vector_type(2)));
typedef unsigned u32x4 __attribute__((ext_vector_type(4)));
typedef unsigned u32x2 __attribute__((ext_vector_type(2)));

constexpr int DM = 1024, NBATCH = 4, SEQ = 4096, ML = NBATCH * SEQ, CTXL = 256, MC = NBATCH * CTXL, MT = ML + MC;
constexpr int DFF = 2816, PIN = 5888, NMODC = 9 * DM;
constexpr int PW = 1792;
constexpr int VTR = 1792;
constexpr int BRW = 1536;
constexpr int GLW = 3072;
constexpr float EPS = 1e-6f;

constexpr size_t MiB = 1u << 20;
constexpr size_t WS_MOD = 64 * 1024;
constexpr size_t WS_ROPE = 512 * 1024;
constexpr size_t WS_TW = 640 * 1024;
constexpr size_t WS_FB1 = 768 * 1024;
constexpr size_t WS_A3 = 896 * 1024;
constexpr size_t WS_SM = 1 * MiB;
constexpr int SM_GF1 = 0, SM_GMIX = 2048, SM_GF2 = 4096, SM_GFIN = 6144, SM_SINK = 7168, SM_BIAS = 7232, SM_END = 7232 + 7440;
constexpr size_t WS_RSQ = 1 * MiB + 128 * 1024;
constexpr size_t WS_CNT = 1 * MiB + 256 * 1024;
constexpr size_t WS_W = 2 * MiB, WS_WL = 52 * MiB;
constexpr size_t WO_13A = 0, WO_2A = 11 * MiB, WO_IN = WO_2A + 11 * MiB / 2, WO_INT = WO_IN + 7 * MiB / 2, WO_G = WO_INT + 7 * MiB / 2,
                 WO_BR = WO_G + 6 * MiB, WO_OUT = WO_BR + 3 * MiB, WO_13B = WO_OUT + 2 * MiB, WO_2B = WO_13B + 11 * MiB;
static_assert(WO_2B + 11 * MiB / 2 <= WS_WL, "weights");
constexpr size_t WS_HC = 106 * MiB;
constexpr size_t WS_U = 110 * MiB;
constexpr size_t WS_BR = 144 * MiB;
constexpr size_t WS_R1 = 195 * MiB;
constexpr size_t WS_VT = WS_R1 + (size_t)MT * PW * 2;
constexpr size_t WS_END = WS_R1 + 119 * MiB;
static_assert((size_t)MT * GLW * 2 <= 119 * MiB && (size_t)MT * DFF * 2 <= 119 * MiB && (size_t)MT * PW * 4 <= 119 * MiB, "R1");

constexpr int LDS_BYTES = 163840;
constexpr int LDS_X = 131072;

__device__ __forceinline__ int lane_now() { int l; asm volatile("v_mbcnt_lo_u32_b32 %0, -1, 0\n\tv_mbcnt_hi_u32_b32 %0, -1, %0" : "=v"(l)); return l; }
__device__ __forceinline__ unsigned f2bf(float f) { unsigned u = __builtin_bit_cast(unsigned, f); return (u + 0x7fffu + ((u >> 16) & 1u)) >> 16; }
typedef __bf16 bf16x2_t __attribute__((ext_vector_type(2)));
__device__ __forceinline__ unsigned pk2(float lo, float hi) { const f32x2 v = {lo, hi}; const bf16x2_t b = __builtin_convertvector(v, bf16x2_t); return __builtin_bit_cast(unsigned, b); }
__device__ __forceinline__ float bf2f(unsigned short b) { return __builtin_bit_cast(float, (unsigned)b << 16); }
__device__ __forceinline__ float bflo(unsigned w) { return __builtin_bit_cast(float, w << 16); }
__device__ __forceinline__ float bfhi(unsigned w) { return __builtin_bit_cast(float, w & 0xffff0000u); }
__device__ __forceinline__ float wave_sum(float v) {
#pragma unroll
    for (int o = 1; o < 64; o <<= 1) v += __shfl_xor(v, o);
    return v;
}
__device__ __forceinline__ void sincos_turns(double t, float& s, float& c) {
    const double k = __builtin_rint(t * 4.0); const double r = (t - k * 0.25) * 6.283185307179586476925;
    const double r2 = r * r;
    const double sp = r * (1.0 + r2 * (-1.0 / 6 + r2 * (1.0 / 120 + r2 * (-1.0 / 5040 + r2 * (1.0 / 362880 + r2 * (-1.0 / 39916800 + r2 * (1.0 / 6227020800.0)))))));
    const double cp = 1.0 + r2 * (-0.5 + r2 * (1.0 / 24 + r2 * (-1.0 / 720 + r2 * (1.0 / 40320 + r2 * (-1.0 / 3628800 + r2 * (1.0 / 479001600.0 + r2 * (-1.0 / 87178291200.0)))))));
    const int q = ((int)k) & 3;
    const double ss = (q == 0) ? sp : (q == 1) ? cp : (q == 2) ? -sp : -cp;
    const double cc = (q == 0) ? cp : (q == 1) ? -sp : (q == 2) ? -cp : sp;
    s = (float)ss; c = (float)cc;
}

namespace pg8 {
constexpr int BM = 256, BK = 64, HALF = 128, HTB = HALF * BK * 2, STAGE_BYTES = 8 * HTB, NXCD = 8, WGM = 8;
__device__ __forceinline__ int lds_byte(int r, int c) { const int st = (r >> 4) * 2 + (c >> 5), rr = r & 15, cc = c & 31, ob = rr * 64 + cc * 2; return st * 1024 + (ob ^ (((ob >> 9) & 1) << 5)); }
__device__ __forceinline__ void stage_rc(int b, int& R, int& C) { const int st = b / 1024, sb = b % 1024, swz = sb ^ (((sb >> 9) & 1) << 5); R = (st >> 1) * 16 + swz / 64; C = (st & 1) * 32 + (swz % 64) / 2; }
__device__ __forceinline__ int perm32(int rho) { const int n = rho >> 4, i = rho & 15; return 8 * (i >> 2) + 4 * n + (i & 3); }

struct Unit { int pm, pn, kind; const char* A; const char* B; };

__device__ __forceinline__ void tile_map(int L, int nM, int nN, int& pm, int& pn) {
    const int nwg = nM * nN; int wgid = L;
    { const int q = nwg / NXCD, r = nwg % NXCD, xcd = wgid % NXCD, off = wgid / NXCD; wgid = (xcd < r ? xcd * (q + 1) : r * (q + 1) + (xcd - r) * q) + off; }
    const int nig = WGM * nN, gid = wgid / nig, fm = gid * WGM, gsz = (nM - fm) < WGM ? (nM - fm) : WGM;
    pm = fm + ((wgid % nig) % gsz); pn = (wgid % nig) / gsz;
}

template <class Epi, class Sched>
__device__ __forceinline__ void gemm_phase(const int wv_, LAS unsigned char* lds, const int K, const int lda, const int ldb, const Sched& S, const Epi& E) {
    const int lane = lane_now(), wid = wv_, tid = wid * 64 + lane, wr = wid >> 2, wc = wid & 3, fr = lane & 15, fq = lane >> 4;
    const int nt = K / BK;
    unsigned voffA[2], voffB[2];
#pragma unroll
    for (int i = 0; i < 2; ++i) { int R, C; stage_rc(tid * 16 + i * 8192, R, C); const int Rb = Epi::PERM ? ((R & ~31) + perm32(R & 31)) : R;
        voffA[i] = (unsigned)(R * lda + C) * 2u; voffB[i] = (unsigned)(Rb * ldb + C) * 2u; }
    const size_t kstep = (size_t)(BK * 2);
    const size_t hstepA = (size_t)HALF * lda * 2, hstepB = (size_t)HALF * ldb * 2;
    const unsigned ldsw = (unsigned)wid * 1024u;
    const int aoff = lds_byte(wr * 64 + fr, fq * 8), boff = lds_byte(wc * 32 + fr, fq * 8);
#define PG8_SA(b, h) (((b) * 2 + (h)) * HTB)
#define PG8_SB(b, h) ((4 + (b) * 2 + (h)) * HTB)
#define PG8_STAGE(bufoff, gbase, voff) do { _Pragma("unroll") for (int _i = 0; _i < 2; ++_i) \
        __builtin_amdgcn_global_load_lds((const unsigned*)((const char*)(gbase) + (voff)[_i]), (LAS unsigned*)(lds + (bufoff) + ldsw + _i * 8192), 16, 0, 0); } while (0)
#define PG8_LDA(dst, b, h) do { _Pragma("unroll") for (int m = 0; m < 4; ++m) _Pragma("unroll") for (int k = 0; k < 2; ++k) dst[m][k] = *(const LAS bf16x8*)(lds + PG8_SA(b, h) + aoff + m * 2048 + k * 1024); } while (0)
#define PG8_LDB(dst, b, h) do { _Pragma("unroll") for (int n = 0; n < 2; ++n) _Pragma("unroll") for (int k = 0; k < 2; ++k) dst[n][k] = *(const LAS bf16x8*)(lds + PG8_SB(b, h) + boff + n * 2048 + k * 1024); } while (0)
#define PG8_MMA(ai, bj, At, Bt) do { __builtin_amdgcn_s_setprio(1); _Pragma("unroll") for (int m = 0; m < 4; ++m) _Pragma("unroll") for (int n = 0; n < 2; ++n) _Pragma("unroll") for (int k = 0; k < 2; ++k) \
        acc[ai][bj][m][n] = __builtin_amdgcn_mfma_f32_16x16x32_bf16(Bt[n][k], At[m][k], acc[ai][bj][m][n], 0, 0, 0); __builtin_amdgcn_s_setprio(0); } while (0)
#define PG8_WAIT_V(n) asm volatile("s_waitcnt vmcnt(" #n ")" ::: "memory")
#define PG8_WAIT_L(n) asm volatile("s_waitcnt lgkmcnt(" #n ")" ::: "memory")
#define PG8_BAR __builtin_amdgcn_s_barrier()
#define PG8_SCHED __builtin_amdgcn_sched_barrier(0)
    Unit cur, nxt; int ui = 0;
    if (!S.next(0, cur)) return;
    f32x4 acc[2][2][4][2];
#pragma unroll
    for (int a = 0; a < 2; ++a)
#pragma unroll
        for (int b = 0; b < 2; ++b)
#pragma unroll
            for (int m = 0; m < 4; ++m)
#pragma unroll
                for (int n = 0; n < 2; ++n) acc[a][b][m][n] = (f32x4){0.f, 0.f, 0.f, 0.f};
    bf16x8 At[4][2], B0[2][2], B1[2][2];
    const char* cA = cur.A; const char* cB = cur.B;
    PG8_STAGE(PG8_SB(0, 0), cB, voffB); PG8_STAGE(PG8_SB(0, 1), cB + hstepB, voffB); PG8_STAGE(PG8_SA(0, 0), cA, voffA); PG8_STAGE(PG8_SA(0, 1), cA + hstepA, voffA);
    if (wr == 1) PG8_BAR;
    PG8_WAIT_V(2); PG8_BAR;
    PG8_STAGE(PG8_SB(1, 0), cB + kstep, voffB); PG8_STAGE(PG8_SA(1, 0), cA + kstep, voffA); PG8_STAGE(PG8_SB(1, 1), cB + hstepB + kstep, voffB);
    PG8_WAIT_V(6); PG8_BAR;
    for (;;) {
        const bool has_next = S.next(ui + 1, nxt);
        const char* nA = has_next ? nxt.A : cA; const char* nB = has_next ? nxt.B : cB;
        for (int t = 0; t < nt; t += 2) {
            const bool last = (t == nt - 2);
            const char* a1 = cA + (size_t)(t + 1) * kstep;
            const char* a2 = last ? nA : cA + (size_t)(t + 2) * kstep; const char* b2 = last ? nB : cB + (size_t)(t + 2) * kstep;
            const char* a3 = a2 + kstep; const char* b3 = b2 + kstep;
            PG8_LDB(B0, 0, 0); PG8_LDB(B1, 0, 1); PG8_SCHED; PG8_LDA(At, 0, 0); PG8_STAGE(PG8_SA(1, 1), a1 + hstepA, voffA);
            PG8_WAIT_V(8); PG8_WAIT_L(0); PG8_BAR; PG8_MMA(0, 0, At, B0); PG8_MMA(0, 1, At, B1); PG8_BAR; PG8_SCHED;
            PG8_LDA(At, 0, 1); PG8_STAGE(PG8_SB(0, 0), b2, voffB); PG8_STAGE(PG8_SB(0, 1), b2 + hstepB, voffB); PG8_STAGE(PG8_SA(0, 0), a2, voffA);
            PG8_WAIT_V(8); PG8_WAIT_L(0); PG8_BAR; PG8_MMA(1, 0, At, B0); PG8_MMA(1, 1, At, B1); PG8_BAR; PG8_SCHED;
            PG8_LDB(B0, 1, 0); PG8_LDB(B1, 1, 1); PG8_SCHED; PG8_LDA(At, 1, 0); PG8_STAGE(PG8_SA(0, 1), a2 + hstepA, voffA);
            PG8_WAIT_V(8); PG8_WAIT_L(0); PG8_BAR; PG8_MMA(0, 0, At, B0); PG8_MMA(0, 1, At, B1); PG8_BAR; PG8_SCHED;
            PG8_LDA(At, 1, 1); PG8_STAGE(PG8_SB(1, 0), b3, voffB); PG8_STAGE(PG8_SB(1, 1), b3 + hstepB, voffB); PG8_STAGE(PG8_SA(1, 0), a3, voffA);
            PG8_WAIT_V(8); PG8_WAIT_L(0); PG8_BAR; PG8_MMA(1, 0, At, B0); PG8_MMA(1, 1, At, B1); PG8_BAR; PG8_SCHED;
        }
        if (wr == 0) PG8_BAR;
        E(acc, cur, wr, wc, fr, fq);
        if (!has_next) break;
#pragma unroll
        for (int a = 0; a < 2; ++a)
#pragma unroll
            for (int b = 0; b < 2; ++b)
#pragma unroll
                for (int m = 0; m < 4; ++m)
#pragma unroll
                    for (int n = 0; n < 2; ++n) acc[a][b][m][n] = (f32x4){0.f, 0.f, 0.f, 0.f};
        cur = nxt; cA = nA; cB = nB; ++ui;
        if (wr == 1) PG8_BAR;
    }
    PG8_WAIT_V(0);
    PG8_BAR;
#undef PG8_SA
#undef PG8_SB
#undef PG8_STAGE
#undef PG8_LDA
#undef PG8_LDB
#undef PG8_MMA
#undef PG8_WAIT_V
#undef PG8_WAIT_L
#undef PG8_BAR
#undef PG8_SCHED
}

struct Sched2 {
    int G, c;
    int n0, nM0, nN0; const char* A0; const char* B0; size_t at0, bt0;
    int n1, nM1, nN1; const char* A1; const char* B1; size_t at1, bt1;
    __device__ __forceinline__ bool next(int i, Unit& u) const {
        long L = (long)i * G + c;
        if (L < n0) { tile_map((int)L, nM0, nN0, u.pm, u.pn); u.kind = 0; u.A = A0 + (size_t)u.pm * at0; u.B = B0 + (size_t)u.pn * bt0; return true; }
        L -= n0;
        if (L < n1) { tile_map((int)L, nM1, nN1, u.pm, u.pn); u.kind = 1; u.A = A1 + (size_t)u.pm * at1; u.B = B1 + (size_t)u.pn * bt1; return true; }
        return false;
    }
};
struct SchedMerge {
    int G, c, nM; const char* BR; const char* WBR;
    __device__ __forceinline__ bool next(int i, Unit& u) const {
        const int rnd = i / 3, br = i - 3 * rnd; const long L = (long)rnd * G + c;
        if (L >= (long)nM * 4) return false;
        tile_map((int)L, nM, 4, u.pm, u.pn); u.kind = br;
        u.A = BR + (size_t)u.pm * 256 * BRW * 2 + (size_t)br * 512 * 2;
        u.B = WBR + (size_t)(br * 4 + u.pn) * 256 * 512 * 2;
        return true;
    }
};

struct SchedSplit {
    int G, c, nks; const char* A; const char* B; size_t lda2, ldb2;
    int kq_per; size_t abr;
    __device__ __forceinline__ bool next(int i, Unit& u) const {
        const long L = (long)i * G + c; if (L >= (long)16 * nks) return false;
        const int t = (int)L / nks, ks = (int)L - t * nks; u.pm = t >> 2; u.pn = t & 3; u.kind = ks;
        const int br = ks / kq_per, kq = ks - br * kq_per;
        u.A = A + (size_t)br * abr + (size_t)u.pm * 256 * lda2 + (size_t)kq * 512; u.B = B + (size_t)u.pn * 256 * ldb2 + (size_t)kq * 512; return true;
    }
};
struct SchedMergeCtx {
    int G, c; const char* BR; const char* WBR;
    __device__ __forceinline__ bool next(int i, Unit& u) const {
        const long L = (long)i * G + c; if (L >= 48) return false;
        const int t = (int)L / 3, br = (int)L - 3 * t; u.pm = 64 + (t >> 2); u.pn = t & 3; u.kind = br;
        u.A = BR + (size_t)u.pm * 256 * BRW * 2 + (size_t)br * 512 * 2;
        u.B = WBR + (size_t)(br * 4 + u.pn) * 256 * 512 * 2;
        return true;
    }
};
struct EpiNull { static constexpr bool PERM = false; float* sink;
    __device__ __forceinline__ void operator()(const f32x4 (&acc)[2][2][4][2], const Unit& u, int wr, int wc, int fr, int fq) const {
        f32x4 t = (f32x4){0.f, 0.f, 0.f, 0.f};
#pragma unroll
        for (int ai = 0; ai < 2; ++ai)
#pragma unroll
            for (int bj = 0; bj < 2; ++bj)
#pragma unroll
                for (int m = 0; m < 4; ++m)
#pragma unroll
                    for (int n = 0; n < 2; ++n) t = t + acc[ai][bj][m][n];
        const float q = (t[0] + t[1]) + (t[2] + t[3]);
        if (q == 1.2345678e33f) *sink = q; } };
struct EpiNullP { static constexpr bool PERM = true; float* sink;
    __device__ __forceinline__ void operator()(const f32x4 (&acc)[2][2][4][2], const Unit& u, int wr, int wc, int fr, int fq) const {
        f32x4 t = (f32x4){0.f, 0.f, 0.f, 0.f};
#pragma unroll
        for (int ai = 0; ai < 2; ++ai)
#pragma unroll
            for (int bj = 0; bj < 2; ++bj)
#pragma unroll
                for (int m = 0; m < 4; ++m)
#pragma unroll
                    for (int n = 0; n < 2; ++n) t = t + acc[ai][bj][m][n];
        const float q = (t[0] + t[1]) + (t[2] + t[3]);
        if (q == 1.2345678e33f) *sink = q; } };
struct EpiPart {
    static constexpr bool PERM = true;
    float* PART;
    __device__ __forceinline__ void operator()(const f32x4 (&acc)[2][2][4][2], const Unit& u, int wr, int wc, int fr_, int fq) const {
        int fr = fr_; asm volatile("" : "+v"(fr));
        float* base = PART + ((size_t)u.kind * MC + (size_t)u.pm * BM) * DM;
        const int row0 = wr * 64 + fr; const int col0 = u.pn * BM + wc * 32 + 8 * fq;
#pragma unroll
        for (int ai = 0; ai < 2; ++ai)
#pragma unroll
            for (int m = 0; m < 4; ++m) { float* rowp = base + (size_t)(row0 + ai * HALF + m * 16) * DM + col0;
#pragma unroll
                for (int bj = 0; bj < 2; ++bj) { *(f32x4*)(rowp + bj * HALF) = acc[ai][bj][m][0]; *(f32x4*)(rowp + bj * HALF + 4) = acc[ai][bj][m][1]; } }
    }
};

__device__ __forceinline__ float silu_f(float a) { return a * __builtin_amdgcn_rcpf(1.f + __expf(-a)); }
__device__ __forceinline__ float sigmoid_f(float a) { return __builtin_amdgcn_rcpf(1.f + __expf(-a)); }

struct EpiUp {
    static constexpr bool PERM = true;
    bf16_t* ACT;
    __device__ __forceinline__ void operator()(const f32x4 (&acc)[2][2][4][2], const Unit& u, int wr, int wc, int fr_, int fq) const {
        int fr = fr_; asm volatile("" : "+v"(fr));
        const int row0 = u.pm * BM + wr * 64 + fr; const int col0 = u.pn * 128 + wc * 32 + 8 * fq;
#pragma unroll
        for (int ai = 0; ai < 2; ++ai)
#pragma unroll
            for (int m = 0; m < 4; ++m) {
                bf16_t* rowp = ACT + (size_t)(row0 + ai * HALF + m * 16) * DFF + col0;
                float v[8];
#pragma unroll
                for (int n = 0; n < 2; ++n)
#pragma unroll
                    for (int j = 0; j < 4; ++j) v[4 * n + j] = silu_f(acc[ai][0][m][n][j]) * acc[ai][1][m][n][j];
                u32x4 w; w.x = pk2(v[0], v[1]); w.y = pk2(v[2], v[3]); w.z = pk2(v[4], v[5]); w.w = pk2(v[6], v[7]);
                *(u32x4*)rowp = w;
            }
    }
};
struct EpiRes {
    static constexpr bool PERM = true;
    bf16_t* HL; bf16_t* HCx; const float* gate;
    float coef; bf16_t* HLw;
    __device__ __forceinline__ void operator()(const f32x4 (&acc)[2][2][4][2], const Unit& u, int wr, int wc, int fr_, int fq) const {
        int fr = fr_; asm volatile("" : "+v"(fr));
        bf16_t* base = u.pm < 64 ? HL + (size_t)u.pm * BM * DM : HCx + (size_t)(u.pm - 64) * BM * DM;
        const int bidx = u.pm < 64 ? (u.pm >> 4) : 4;
        const float* gp = gate + (size_t)bidx * NMODC;
        const int row0 = wr * 64 + fr; const int col0 = u.pn * BM + wc * 32 + 8 * fq;
        bf16_t* wbase = u.pm < 64 ? HLw + (size_t)u.pm * BM * DM : base;
#pragma unroll
        for (int bj = 0; bj < 2; ++bj) {
            const f32x4 g0 = *(const f32x4*)(gp + col0 + bj * HALF) * coef, g1 = *(const f32x4*)(gp + col0 + bj * HALF + 4) * coef;
            u32x4 hv[2][4];
#pragma unroll
            for (int ai = 0; ai < 2; ++ai)
#pragma unroll
                for (int m = 0; m < 4; ++m) hv[ai][m] = *(const u32x4*)(base + (size_t)(row0 + ai * HALF + m * 16) * DM + col0 + bj * HALF);
#pragma unroll
            for (int ai = 0; ai < 2; ++ai)
#pragma unroll
                for (int m = 0; m < 4; ++m) { const f32x4 a0 = acc[ai][bj][m][0], a1 = acc[ai][bj][m][1]; const u32x4 h = hv[ai][m]; u32x4 w;
                    w.x = pk2(bflo(h.x) + g0[0] * a0[0], bfhi(h.x) + g0[1] * a0[1]); w.y = pk2(bflo(h.y) + g0[2] * a0[2], bfhi(h.y) + g0[3] * a0[3]);
                    w.z = pk2(bflo(h.z) + g1[0] * a1[0], bfhi(h.z) + g1[1] * a1[1]); w.w = pk2(bflo(h.w) + g1[2] * a1[2], bfhi(h.w) + g1[3] * a1[3]);
                    *(u32x4*)(wbase + (size_t)(row0 + ai * HALF + m * 16) * DM + col0 + bj * HALF) = w; }
        }
    }
};
struct EpiFinal {
    static constexpr bool PERM = true;
    unsigned char* ws; float* out;
    __device__ __forceinline__ void operator()(f32x4 (&acc)[2][2][4][2], const Unit& u, int wr, int wc, int fr_, int fq) const {
        int fr = fr_; asm volatile("" : "+v"(fr));
        const float coef = 0.5f;
        const float* gfin = (const float*)(ws + WS_SM) + SM_GFIN; float* rowsq = (float*)(ws + WS_RSQ); unsigned* cnt = (unsigned*)(ws + WS_CNT);
        const bf16_t* base = (const bf16_t*)(ws + WS_BR) + (size_t)u.pm * BM * DM;
        const float* gp = (const float*)(ws + WS_MOD) + (size_t)5 * NMODC + 8 * DM + (size_t)(u.pm >> 4) * NMODC;
        const int row0 = wr * 64 + fr; const int col0 = u.pn * BM + wc * 32 + 8 * fq;
#pragma unroll
        for (int bj = 0; bj < 2; ++bj) {
            const f32x4 g0 = *(const f32x4*)(gp + col0 + bj * HALF) * coef, g1 = *(const f32x4*)(gp + col0 + bj * HALF + 4) * coef;
            u32x4 hv[2][4];
#pragma unroll
            for (int ai = 0; ai < 2; ++ai)
#pragma unroll
                for (int m = 0; m < 4; ++m) hv[ai][m] = *(const u32x4*)(base + (size_t)(row0 + ai * HALF + m * 16) * DM + col0 + bj * HALF);
#pragma unroll
            for (int ai = 0; ai < 2; ++ai)
#pragma unroll
                for (int m = 0; m < 4; ++m) { const u32x4 h = hv[ai][m]; const f32x4 a0 = acc[ai][bj][m][0], a1 = acc[ai][bj][m][1];
                    acc[ai][bj][m][0] = (f32x4){bflo(h.x), bfhi(h.x), bflo(h.y), bfhi(h.y)} + g0 * a0;
                    acc[ai][bj][m][1] = (f32x4){bflo(h.z), bfhi(h.z), bflo(h.w), bfhi(h.w)} + g1 * a1; }
        }
        float* rq = rowsq + (size_t)u.pm * BM + row0;
#pragma unroll
        for (int ai = 0; ai < 2; ++ai)
#pragma unroll
            for (int m = 0; m < 4; ++m) { float sq = 0.f;
#pragma unroll
                for (int bj = 0; bj < 2; ++bj)
#pragma unroll
                    for (int n = 0; n < 2; ++n) { const f32x4 x = acc[ai][bj][m][n]; sq += (x[0] * x[0] + x[1] * x[1]) + (x[2] * x[2] + x[3] * x[3]); }
                sq += __shfl_xor(sq, 16); sq += __shfl_xor(sq, 32);
                if (fq == 0) (void)__hip_atomic_fetch_add(rq + ai * HALF + m * 16, sq, __ATOMIC_RELAXED, __HIP_MEMORY_SCOPE_AGENT); }
        __builtin_amdgcn_s_waitcnt(0);
        unsigned* cw = cnt + 64 * u.pm;
        if (fr_ == 0 && fq == 0) (void)__hip_atomic_fetch_add(cw, 1u, __ATOMIC_RELAXED, __HIP_MEMORY_SCOPE_AGENT);
        { unsigned it = 0;
          while (__hip_atomic_load(cw, __ATOMIC_RELAXED, __HIP_MEMORY_SCOPE_AGENT) < 32u) { __builtin_amdgcn_s_sleep(2); if (++it > (1u << 20)) break; } }
        float* ob = out + (size_t)u.pm * BM * DM;
#pragma unroll
        for (int ai = 0; ai < 2; ++ai)
#pragma unroll
            for (int m = 0; m < 4; ++m) {
                const float rs = __hip_atomic_load(rq + ai * HALF + m * 16, __ATOMIC_RELAXED, __HIP_MEMORY_SCOPE_AGENT);
                const float rstd = 1.0f / sqrtf(rs * (1.f / DM) + EPS);
#pragma unroll
                for (int bj = 0; bj < 2; ++bj) { const f32x4 f0 = *(const f32x4*)(gfin + col0 + bj * HALF), f1 = *(const f32x4*)(gfin + col0 + bj * HALF + 4);
                    float* op = ob + (size_t)(row0 + ai * HALF + m * 16) * DM + col0 + bj * HALF;
                    *(f32x4*)op = acc[ai][bj][m][0] * rstd * f0; *(f32x4*)(op + 4) = acc[ai][bj][m][1] * rstd * f1; }
            }
    }
};
struct EpiWin {
    static constexpr bool PERM = true;
    bf16_t* P; bf16_t* VT; const float* rope;
    __device__ __forceinline__ void operator()(const f32x4 (&acc)[2][2][4][2], const Unit& u, int wr, int wc, int fr_, int fq) const {
        int fr = fr_; asm volatile("" : "+v"(fr));
        const int row0 = u.pm * BM + wr * 64 + fr;
        if (u.kind == 0) {
            const bool rp = (u.pm < 64) && (u.pn == 4 || u.pn == 5 || (u.pn == 6 && wc < 2));
            const int colb = u.pn * BM + wc * 64 + 8 * fq;
#pragma unroll
            for (int ai = 0; ai < 2; ++ai)
#pragma unroll
                for (int m = 0; m < 4; ++m) {
                    const int row = row0 + ai * HALF + m * 16;
                    float x1[8], x2[8];
#pragma unroll
                    for (int n = 0; n < 2; ++n)
#pragma unroll
                        for (int j = 0; j < 4; ++j) { x1[4 * n + j] = acc[ai][0][m][n][j]; x2[4 * n + j] = acc[ai][1][m][n][j]; }
                    if (rp) {
                        const int t = row & 4095; const int pos = (fq < 2) ? (t >> 6) : (t & 63);
                        const f32x4* rt = (const f32x4*)(rope + ((size_t)pos * 16 + (fq & 1) * 8) * 2);
#pragma unroll
                        for (int q = 0; q < 4; ++q) { const f32x4 cs = rt[q];
                            const float a0 = x1[2 * q], b0 = x2[2 * q], a1 = x1[2 * q + 1], b1 = x2[2 * q + 1];
                            x1[2 * q] = a0 * cs[0] - b0 * cs[1]; x2[2 * q] = a0 * cs[1] + b0 * cs[0];
                            x1[2 * q + 1] = a1 * cs[2] - b1 * cs[3]; x2[2 * q + 1] = a1 * cs[3] + b1 * cs[2]; }
                    }
                    bf16_t* rowp = P + (size_t)row * PW + colb;
                    u32x4 w; w.x = pk2(x1[0], x1[1]); w.y = pk2(x1[2], x1[3]); w.z = pk2(x1[4], x1[5]); w.w = pk2(x1[6], x1[7]);
                    *(u32x4*)rowp = w;
                    w.x = pk2(x2[0], x2[1]); w.y = pk2(x2[2], x2[3]); w.z = pk2(x2[4], x2[5]); w.w = pk2(x2[6], x2[7]);
                    *(u32x4*)(rowp + 32) = w;
                }
        } else {
            const int col0 = u.pn * BM + wc * 32 + 8 * fq;
#pragma unroll
            for (int ai = 0; ai < 2; ++ai)
#pragma unroll
                for (int m = 0; m < 4; ++m) {
                    const int r = row0 + ai * HALF + m * 16;
                    if (u.pm < 3) {
                        bf16_t* vp = VT + (size_t)(r >> 6) * ((size_t)MT * 64) + (size_t)(col0 >> 2) * 256 + (r & 63) * 4;
#pragma unroll
                        for (int bj = 0; bj < 2; ++bj) { const f32x4 v0 = acc[ai][bj][m][0], v1 = acc[ai][bj][m][1];
                            u32x2 w; w.x = pk2(v0[0], v0[1]); w.y = pk2(v0[2], v0[3]); *(u32x2*)(vp + bj * 32 * 256) = w;
                            w.x = pk2(v1[0], v1[1]); w.y = pk2(v1[2], v1[3]); *(u32x2*)(vp + bj * 32 * 256 + 256) = w; }
                    } else {
                    bf16_t* rowp = VT + (size_t)r * MT + col0;
#pragma unroll
                    for (int bj = 0; bj < 2; ++bj) { const f32x4 v0 = acc[ai][bj][m][0], v1 = acc[ai][bj][m][1];
                        u32x4 w; w.x = pk2(v0[0], v0[1]); w.y = pk2(v0[2], v0[3]); w.z = pk2(v1[0], v1[1]); w.w = pk2(v1[2], v1[3]);
                        *(u32x4*)(rowp + bj * HALF) = w; }
                    }
                }
        }
    }
};
struct EpiGate {
    static constexpr bool PERM = true;
    bf16_t* GL;
    __device__ __forceinline__ void operator()(const f32x4 (&acc)[2][2][4][2], const Unit& u, int wr, int wc, int fr_, int fq) const {
        int fr = fr_; asm volatile("" : "+v"(fr));
        const int row0 = u.pm * BM + wr * 64 + fr; const int col0 = u.pn * BM + wc * 32 + 8 * fq;
#pragma unroll
        for (int ai = 0; ai < 2; ++ai)
#pragma unroll
            for (int m = 0; m < 4; ++m) {
                bf16_t* rowp = GL + (size_t)(row0 + ai * HALF + m * 16) * GLW + col0;
#pragma unroll
                for (int bj = 0; bj < 2; ++bj) { const f32x4 v0 = acc[ai][bj][m][0], v1 = acc[ai][bj][m][1];
                    u32x4 w; w.x = pk2(sigmoid_f(v0[0]), sigmoid_f(v0[1])); w.y = pk2(sigmoid_f(v0[2]), sigmoid_f(v0[3]));
                    w.z = pk2(sigmoid_f(v1[0]), sigmoid_f(v1[1])); w.w = pk2(sigmoid_f(v1[2]), sigmoid_f(v1[3]));
                    *(u32x4*)(rowp + bj * HALF) = w; }
            }
    }
};
struct EpiMerge {
    static constexpr bool PERM = true;
    const bf16_t* GL; bf16_t* MG; bf16_t* MGP;
    __device__ __forceinline__ void operator()(const f32x4 (&acc)[2][2][4][2], const Unit& u, int wr, int wc, int fr_, int fq) const {
        int fr = fr_; asm volatile("" : "+v"(fr));
        const int row0 = u.pm * BM + wr * 64 + fr; const int col0 = u.pn * BM + wc * 32 + 8 * fq;
#pragma unroll
        for (int ai = 0; ai < 2; ++ai)
#pragma unroll
            for (int m = 0; m < 4; ++m) {
                const size_t row = (size_t)(row0 + ai * HALF + m * 16);
#pragma unroll
                for (int bj = 0; bj < 2; ++bj) {
                    const u32x4 g = *(const u32x4*)(GL + row * GLW + u.kind * 1024 + col0 + bj * HALF);
                    u32x4* mp = MGP ? (u32x4*)(MGP + ((size_t)u.kind * MC + (row - ML)) * DM + col0 + bj * HALF) : (u32x4*)(MG + row * DM + col0 + bj * HALF);
                    const f32x4 v0 = acc[ai][bj][m][0], v1 = acc[ai][bj][m][1];
                    float r[8];
                    r[0] = bflo(g.x) * v0[0]; r[1] = bfhi(g.x) * v0[1]; r[2] = bflo(g.y) * v0[2]; r[3] = bfhi(g.y) * v0[3];
                    r[4] = bflo(g.z) * v1[0]; r[5] = bfhi(g.z) * v1[1]; r[6] = bflo(g.w) * v1[2]; r[7] = bfhi(g.w) * v1[3];
                    if (u.kind != 0 && !MGP) { const u32x4 o = *mp;
                        r[0] += bflo(o.x); r[1] += bfhi(o.x); r[2] += bflo(o.y); r[3] += bfhi(o.y); r[4] += bflo(o.z); r[5] += bfhi(o.z); r[6] += bflo(o.w); r[7] += bfhi(o.w); }
                    u32x4 w; w.x = pk2(r[0], r[1]); w.y = pk2(r[2], r[3]); w.z = pk2(r[4], r[5]); w.w = pk2(r[6], r[7]);
                    *mp = w;
                }
            }
    }
};
}


#define XB_TMO      128
#define XB_XCNT(j)  (256  + 64 * (j))
#define XB_XSUB(j)  (1280 + 64 * (j))
#define XB_XGEN(j)  (2304 + 64 * (j))
#define XB_TOP      3328
#define XB_TOPGEN   3392
#define XCD_BAR_WORDS 3456
#define XB_SPIN_CAP (1u << 18)
__device__ __forceinline__ unsigned xb_ld(unsigned* p)              { return __hip_atomic_load(p, __ATOMIC_RELAXED, __HIP_MEMORY_SCOPE_AGENT); }
__device__ __forceinline__ unsigned xb_add(unsigned* p, unsigned v) { return __hip_atomic_fetch_add(p, v, __ATOMIC_RELAXED, __HIP_MEMORY_SCOPE_AGENT); }
__device__ __forceinline__ unsigned xb_xcc_id() { return (unsigned)__builtin_amdgcn_s_getreg((3 << 11) | 20) & 0xFu; }
#define XB_SPIN(cond, bar) do { unsigned _sp = 0; while (cond) { __builtin_amdgcn_s_sleep(1); \
    if ((++_sp & 255u) == 0u) { if (xb_ld(&(bar)[XB_TMO])) break; if (_sp > XB_SPIN_CAP) { atomicAdd(&(bar)[XB_TMO], 1u); break; } } } } while (0)
struct XcdBarrier { unsigned* bar; unsigned x; volatile LAS unsigned* st; int wv; };
__device__ __forceinline__ XcdBarrier xcd_barrier_post(unsigned* bar, volatile LAS unsigned* st, int wv) {
    XcdBarrier b; b.bar = bar; b.x = xb_xcc_id(); b.st = st; b.wv = wv;
    if (wv == 0 && lane_now() == 0) (void)xb_add(&bar[XB_XCNT(b.x)], 1u);
    return b;
}
__device__ __forceinline__ void xcd_barrier_complete(unsigned* bar, unsigned x, unsigned& nloc, unsigned& nx) {
    const unsigned G = gridDim.x * gridDim.y * gridDim.z;
    unsigned sum, cnt, mine, sp = 0u;
    for (;;) {
        sum = 0u; cnt = 0u; mine = 0u;
#pragma unroll
        for (unsigned j = 0; j < 16; ++j) { const unsigned c = xb_ld(&bar[XB_XCNT(j)]); sum += c; cnt += (c > 0u) ? 1u : 0u; mine = (j == x) ? c : mine; }
        if (sum == G) break;
        __builtin_amdgcn_s_sleep(1);
        if ((++sp & 255u) == 0u) { if (xb_ld(&bar[XB_TMO])) break; if (sp > XB_SPIN_CAP) { atomicAdd(&bar[XB_TMO], 1u); break; } }
    }
    nloc = mine > 0u ? mine : 1u; nx = cnt > 0u ? cnt : 1u;
}
__device__ __forceinline__ void xcd_barrier(const XcdBarrier& b) {
    asm volatile("s_waitcnt vmcnt(0)" ::: "memory");
    __syncthreads();
    if (b.wv == 0 && lane_now() == 0) {
        unsigned* bar = b.bar;
        __builtin_amdgcn_s_waitcnt(0);
        unsigned nloc = b.st[0], nx = b.st[1];
        if (nloc == 0u) { xcd_barrier_complete(bar, b.x, nloc, nx); b.st[0] = nloc; b.st[1] = nx; }
        const unsigned old = xb_add(&bar[XB_XSUB(b.x)], 1u);
        const unsigned gen = old / nloc;
        if (old + 1u == (gen + 1u) * nloc) {
            __builtin_amdgcn_fence(__ATOMIC_RELEASE, "agent");
            asm volatile("s_waitcnt vmcnt(0)" ::: "memory");
            const unsigned og = xb_add(&bar[XB_TOP], 1u);
            const unsigned tg = og / nx;
            if (og + 1u == (tg + 1u) * nx) xb_add(&bar[XB_TOPGEN], 1u);
            else XB_SPIN(xb_ld(&bar[XB_TOPGEN]) == tg, bar);
            __builtin_amdgcn_fence(__ATOMIC_ACQUIRE, "agent");
            xb_add(&bar[XB_XGEN(b.x)], 1u);
            asm volatile("s_waitcnt vmcnt(0)" ::: "memory");
        } else {
            XB_SPIN(xb_ld(&bar[XB_XGEN(b.x)]) == gen, bar);
            __builtin_amdgcn_fence(__ATOMIC_ACQUIRE, "agent");
            asm volatile("s_waitcnt vmcnt(0)" ::: "memory");
        }
    }
    __syncthreads();
}

struct Args {
    const float* x; const float* c; const float* ctx; const float* c_ctx; const float* w_ada; const float* b_ada; const float* g_ffn1; const float* ffn1_w13; const float* ffn1_w2;
    const float* g_mix; const float* w_in; const float* na_bias; const float* wa_sink; const float* w_br; const float* w_out; const float* g_ffn2; const float* ffn2_w13; const float* ffn2_w2; const float* g_final;
    float* out; unsigned char* ws; int ph_lo, ph_hi;
};

struct Ctx { float* out; unsigned char* ws; const float* x; const float* ctx; int wv; };
__device__ __forceinline__ void transpose_item(const float* W, int K, int Nsrc, int src, bf16_t* WT, int nrow0, int kb, LAS float* scr, int lane) {
    const int k0 = 64 * kb;
    if (src >= 0) {
        float t[32];
#pragma unroll
        for (int i = 0; i < 32; ++i) { const int kk = 2 * i + (lane >> 5); t[i] = W[(size_t)(k0 + kk) * Nsrc + src + (lane & 31)]; }
#pragma unroll
        for (int i = 0; i < 32; ++i) { const int kk = 2 * i + (lane >> 5); scr[kk * 33 + (lane & 31)] = t[i]; }
    } else {
#pragma unroll 8
        for (int i = 0; i < 32; ++i) { const int kk = 2 * i + (lane >> 5); scr[kk * 33 + (lane & 31)] = 0.f; }
    }
    asm volatile("s_waitcnt lgkmcnt(0)" ::: "memory");
    const int c = lane & 7;
#pragma unroll
    for (int j = 0; j < 4; ++j) { const int n = (lane >> 3) + 8 * j; const LAS float* s = scr + (8 * c) * 33 + n;
        u32x4 o; o.x = pk2(s[0 * 33], s[1 * 33]); o.y = pk2(s[2 * 33], s[3 * 33]); o.z = pk2(s[4 * 33], s[5 * 33]); o.w = pk2(s[6 * 33], s[7 * 33]);
        *(u32x4*)(WT + (size_t)(nrow0 + n) * K + k0 + 8 * c) = o; }
    asm volatile("s_waitcnt lgkmcnt(0)" ::: "memory");
}

__device__ __forceinline__ void prep_phase(const Args& a, const int wv_, LAS unsigned char* lds, int G) {
    const int lane = lane_now(), wave = wv_, tid = wave * 64 + lane;
    const int gw = blockIdx.x * 8 + wave, NGW = G * 8;
    LAS float* scr = (LAS float*)(lds + wave * 16384);
    LAS float* tab = (LAS float*)(lds + LDS_X);

    if (tid < 64) { float s, c; sincos_turns((double)tid / 64.0, s, c); tab[tid] = c; tab[64 + tid] = s; }
    __syncthreads();
    constexpr int I13 = 176 * 16, I2 = 32 * 44, IIN = 56 * 16, IINT = 24 * 16, IG = 96 * 16, IBR = 3 * 32 * 8, IOUT = 32 * 16;
    constexpr int IL = 2 * I13 + 2 * I2 + IIN + IINT + IG + IBR + IOUT;
    for (int it = gw; it < 2 * IL; it += NGW) {
        const int l = it / IL; int r = it - l * IL;
        unsigned char* wl = a.ws + WS_W + (size_t)l * WS_WL;
        if (r < 2 * I13) { const int which = r / I13; r -= which * I13; const int gi = r >> 4, kb = r & 15; const int pn = gi >> 3, sub = gi & 7;
            const int src = (sub >> 2) * DFF + 128 * pn + 32 * (sub & 3);
            transpose_item((which ? a.ffn2_w13 : a.ffn1_w13) + (size_t)l * DM * 2 * DFF, DM, 2 * DFF, src, (bf16_t*)(wl + (which ? WO_13B : WO_13A)), 32 * gi, kb, scr, lane); continue; }
        r -= 2 * I13;
        if (r < 2 * I2) { const int which = r / I2; r -= which * I2; const int gi = r / 44, kb = r - gi * 44;
            transpose_item((which ? a.ffn2_w2 : a.ffn1_w2) + (size_t)l * DFF * DM, DFF, DM, 32 * gi, (bf16_t*)(wl + (which ? WO_2B : WO_2A)), 32 * gi, kb, scr, lane); continue; }
        r -= 2 * I2;
        const float* win = a.w_in + (size_t)l * DM * PIN;
        if (r < IIN) { const int gi = r >> 4, kb = r & 15; const int pn = gi >> 3, bj = (gi & 7) >> 2, wc = gi & 3, hp = 4 * pn + wc;
            const int src = (hp < 16 ? 64 * hp : 2048 + 64 * (hp - 16)) + 32 * bj;
            transpose_item(win, DM, PIN, src, (bf16_t*)(wl + WO_IN), 32 * gi, kb, scr, lane); continue; }
        r -= IIN;
        if (r < IINT) { const int gi = r >> 4, kb = r & 15; const int src = gi < 16 ? 1024 + 32 * gi : (gi < 20 ? 2688 + 32 * (gi - 16) : -1);
            transpose_item(win, DM, PIN, src, (bf16_t*)(wl + WO_INT), 32 * gi, kb, scr, lane); continue; }
        r -= IINT;
        if (r < IG) { const int gi = r >> 4, kb = r & 15;
            transpose_item(win, DM, PIN, 2816 + 32 * gi, (bf16_t*)(wl + WO_G), 32 * gi, kb, scr, lane); continue; }
        r -= IG;
        if (r < IBR) { const int br = r / 256; r -= br * 256; const int gi = r >> 3, kb = r & 7;
            transpose_item(a.w_br + ((size_t)l * 3 + br) * 512 * DM, 512, DM, 32 * gi, (bf16_t*)(wl + WO_BR), br * 1024 + 32 * gi, kb, scr, lane); continue; }
        r -= IBR;
        { const int gi = r >> 4, kb = r & 15;
          transpose_item(a.w_out + (size_t)l * DM * DM, DM, DM, 32 * gi, (bf16_t*)(wl + WO_OUT), 32 * gi, kb, scr, lane); }
    }
    for (int it = gw; it < 2 * 8 * 128; it += NGW) {
        const int l = it >> 10, grp = (it >> 7) & 7, k0 = (it & 127) * 8;
        const float* win = a.w_in + (size_t)l * DM * PIN + 1536 + grp * 64;
        bf16_t* wt = (bf16_t*)(a.ws + WS_W + (size_t)l * WS_WL + WO_INT);
        float yr[8], yi[8];
#pragma unroll
        for (int kk = 0; kk < 8; ++kk) { yr[kk] = 0.f; yi[kk] = 0.f; }
        for (int c = 0; c < 64; ++c) {
            const int idx = (c * lane) & 63; const float cs = tab[idx], sn = tab[64 + idx];
#pragma unroll
            for (int kk = 0; kk < 8; ++kk) { const float w = win[(size_t)(k0 + kk) * PIN + c]; yr[kk] += w * cs; yi[kk] -= w * sn; }
        }
        u32x4 o; o.x = pk2(yr[0] * 0.125f, yr[1] * 0.125f); o.y = pk2(yr[2] * 0.125f, yr[3] * 0.125f); o.z = pk2(yr[4] * 0.125f, yr[5] * 0.125f); o.w = pk2(yr[6] * 0.125f, yr[7] * 0.125f);
        *(u32x4*)(wt + (size_t)(768 + grp * 64 + lane) * DM + k0) = o;
        o.x = pk2(yi[0] * 0.125f, yi[1] * 0.125f); o.y = pk2(yi[2] * 0.125f, yi[3] * 0.125f); o.z = pk2(yi[4] * 0.125f, yi[5] * 0.125f); o.w = pk2(yi[6] * 0.125f, yi[7] * 0.125f);
        *(u32x4*)(wt + (size_t)(1280 + grp * 64 + lane) * DM + k0) = o;
    }
    {
        const int gt = blockIdx.x * 512 + tid, NT = G * 512;
        float2* rope = (float2*)(a.ws + WS_ROPE);
        for (int e = gt; e < 64 * 16; e += NT) { const int pos = e >> 4, f = e & 15;
            const float c4 = (f & 3) == 0 ? 1.0f : (f & 3) == 1 ? 0.56234132519034908f : (f & 3) == 2 ? 0.31622776601683794f : 0.17782794100389228f;
            const float p10 = (f >> 2) == 0 ? 1.0f : (f >> 2) == 1 ? 0.1f : (f >> 2) == 2 ? 0.01f : 0.001f;
            const float ang = (float)pos * (c4 * p10);
            const double tt = (double)ang * 0.15915494309189533577; const double fr = tt - __builtin_floor(tt);
            float s, c; sincos_turns(fr, s, c); rope[e] = make_float2(c, s); }
        float2* tw = (float2*)(a.ws + WS_TW);
        for (int e = gt; e < 64 * 64; e += NT) { const int n2 = e >> 6, n1p = e & 63; float s, c; sincos_turns((double)(n2 * n1p) / 4096.0, s, c); tw[e] = make_float2(c * (1.f / 64.f), s * (1.f / 64.f)); }
        bf16_t* fb1 = (bf16_t*)(a.ws + WS_FB1);
        for (int e = gt; e < 4 * 8 * 64 * 8; e += NT) { const int j = e & 7, ln = (e >> 3) & 63, nt = (e >> 9) & 7, ks = e >> 12; const int g = ln >> 4;
            const int k = 32 * ks + 8 * g + j, n = 16 * nt + (ln & 15); const int pk = k >> 6, n1 = k & 63, pn = n >> 6, n1p = n & 63;
            const int q = (n1 * n1p) & 63; const float cs = tab[q], sn = tab[64 + q];
            const float v = (pk == pn) ? cs : (pk == 0 ? -sn : sn);
            fb1[e] = (bf16_t)f2bf(v); }
        bf16_t* a3 = (bf16_t*)(a.ws + WS_A3);
        for (int e = gt; e < 4 * 4 * 64 * 8; e += NT) { const int j = e & 7, ln = (e >> 3) & 63, ks3 = (e >> 9) & 3, m3 = e >> 11; const int g = ln >> 4;
            const int n2p = 16 * m3 + (ln & 15); const int mtA = 2 * (ks3 & 1) + (j >> 2); const int n2 = 16 * mtA + 4 * g + (j & 3);
            const int q = (n2 * n2p) & 63; const float v = (ks3 < 2) ? tab[q] : tab[64 + q];
            a3[e] = (bf16_t)f2bf(v); }
    }
    __syncthreads();
    LAS float* sv = (LAS float*)lds;
    LAS float* red = (LAS float*)(lds + 32768);
    for (int e = tid; e < 5 * DM; e += 512) { const int r = e >> 10, k = e & 1023; const float v = r < 4 ? a.c[r * DM + k] : a.c_ctx[k]; sv[e] = v / (1.f + __expf(-v)); }
    __syncthreads();
    float* mod = (float*)(a.ws + WS_MOD);
    for (int it = blockIdx.x; it < 2 * 144; it += G) {
        const int l = it / 144, n0 = (it - l * 144) * 64;
        const float* w = a.w_ada + (size_t)l * DM * NMODC + n0 + lane;
        float ac[5] = {0.f, 0.f, 0.f, 0.f, 0.f};
        const int kbeg = wave * 128;
#pragma unroll 8
        for (int k = kbeg; k < kbeg + 128; ++k) { const float wv = w[(size_t)k * NMODC];
#pragma unroll
            for (int r = 0; r < 5; ++r) ac[r] += sv[r * DM + k] * wv; }
#pragma unroll
        for (int r = 0; r < 5; ++r) red[(wave * 5 + r) * 64 + lane] = ac[r];
        __syncthreads();
        if (tid < 320) { const int r = tid >> 6; float s = 0.f;
#pragma unroll
            for (int wv = 0; wv < 8; ++wv) s += red[(wv * 5 + r) * 64 + lane];
            mod[((size_t)l * 5 + r) * NMODC + n0 + lane] = s + a.b_ada[(size_t)l * NMODC + n0 + lane]; }
        __syncthreads();
    }
    {
        const int gt = blockIdx.x * 512 + tid, NT = G * 512;
        float* sm = (float*)(a.ws + WS_SM);
        { unsigned* z0 = (unsigned*)(a.ws + WS_RSQ); unsigned* z1 = (unsigned*)(a.ws + WS_CNT); for (int e = gt; e < ML; e += NT) z0[e] = 0u; for (int e = gt; e < 64 * 64; e += NT) z1[e] = 0u; }
        for (int e = gt; e < SM_END; e += NT) { float v;
            if (e < SM_GMIX) v = a.g_ffn1[e]; else if (e < SM_GF2) v = a.g_mix[e - SM_GMIX]; else if (e < SM_GFIN) v = a.g_ffn2[e - SM_GF2]; else if (e < SM_SINK) v = a.g_final[e - SM_GFIN];
            else if (e < SM_BIAS) v = (e - SM_SINK) < 16 ? a.wa_sink[e - SM_SINK] : 0.f; else v = a.na_bias[e - SM_BIAS];
            sm[e] = v; }
    }
}

__device__ __forceinline__ bf16_t* h_lat(const Ctx& a) { return (bf16_t*)a.out + (size_t)ML * DM; }
__device__ __forceinline__ f32x4 ld_h4(const bf16_t* p) { const u32x2 w = *(const u32x2*)p; return (f32x4){bflo(w.x), bfhi(w.x), bflo(w.y), bfhi(w.y)}; }
__device__ __forceinline__ void st_h4(bf16_t* p, f32x4 v) { u32x2 w; w.x = pk2(v[0], v[1]); w.y = pk2(v[2], v[3]); *(u32x2*)p = w; }
template <int MODE, int NPARTS = 0>
__device__ __forceinline__ void norm_phase(const Ctx& a, int G, int nrows, const float* gvec, const float* modl, int shidx, const float* pgate = nullptr, float pcoef = 0.f, bf16_t* hsrc = nullptr) {
    const int lane = lane_now(), wave = a.wv;
    const int gw = blockIdx.x * 8 + wave, NGW = G * 8;
    bf16_t* HL = hsrc ? hsrc : h_lat(a); bf16_t* HCx = (bf16_t*)(a.ws + WS_HC); bf16_t* U = (bf16_t*)(a.ws + WS_U);
    const float* part = (const float*)(a.ws + WS_BR);
    for (int row0 = gw * 4; row0 < ML; row0 += NGW * 4) {
        bf16_t* hrow = HL + (size_t)row0 * DM;
        f32x4 v[4][4]; float ss[4];
#pragma unroll
        for (int r = 0; r < 4; ++r) { ss[r] = 0.f;
#pragma unroll
            for (int j = 0; j < 4; ++j) v[r][j] = (MODE == 1) ? *(const f32x4*)(a.x + (size_t)(row0 + r) * DM + 4 * lane + 256 * j) : ld_h4(hrow + (size_t)r * DM + 4 * lane + 256 * j); }
        if (MODE == 1) {
#pragma unroll
            for (int r = 0; r < 4; ++r)
#pragma unroll
                for (int j = 0; j < 4; ++j) { st_h4(hrow + (size_t)r * DM + 4 * lane + 256 * j, v[r][j]); v[r][j] = ld_h4(hrow + (size_t)r * DM + 4 * lane + 256 * j); }
        }
#pragma unroll
        for (int r = 0; r < 4; ++r) {
#pragma unroll
            for (int j = 0; j < 4; ++j) ss[r] += (v[r][j][0] * v[r][j][0] + v[r][j][1] * v[r][j][1]) + (v[r][j][2] * v[r][j][2] + v[r][j][3] * v[r][j][3]);
            ss[r] = 1.0f / sqrtf(wave_sum(ss[r]) * (1.f / DM) + EPS); }
        const int bidx = row0 >> 12;
        const float* sh = modl + (size_t)bidx * NMODC + shidx * DM; const float* sc = sh + DM;
#pragma unroll
        for (int j = 0; j < 4; ++j) { const f32x4 s1 = *(const f32x4*)(sc + 4 * lane + 256 * j), s0 = *(const f32x4*)(sh + 4 * lane + 256 * j), gv = *(const f32x4*)(gvec + 4 * lane + 256 * j);
            const f32x4 mul = gv * (s1 + 1.0f);
#pragma unroll
            for (int r = 0; r < 4; ++r) { const f32x4 o = (v[r][j] * ss[r]) * mul + s0;
                u32x2 w; w.x = pk2(o[0], o[1]); w.y = pk2(o[2], o[3]);
                *(u32x2*)(U + (size_t)(row0 + r) * DM + 4 * lane + 256 * j) = w; } }
    }
    for (int cr = (NGW - 1 - gw); cr < nrows - ML; cr += NGW) {
        bf16_t* hrow = HCx + (size_t)cr * DM;
        f32x4 v[4];
#pragma unroll
        for (int j = 0; j < 4; ++j) v[j] = (MODE == 1) ? *(const f32x4*)(a.ctx + (size_t)cr * DM + 4 * lane + 256 * j) : ld_h4(hrow + 4 * lane + 256 * j);
        if (NPARTS > 0) {
#pragma unroll
            for (int j = 0; j < 4; ++j) { f32x4 pv[NPARTS > 0 ? NPARTS : 1];
#pragma unroll
                for (int ks = 0; ks < NPARTS; ++ks) pv[ks] = *(const f32x4*)(part + ((size_t)ks * MC + cr) * DM + 4 * lane + 256 * j);
                f32x4 sum = pv[0];
#pragma unroll
                for (int ks = 1; ks < NPARTS; ++ks) sum = sum + pv[ks];
                const f32x4 gt = *(const f32x4*)(pgate + 4 * lane + 256 * j) * pcoef;
                v[j] = v[j] + gt * sum; }
        }
        if (MODE == 1 || NPARTS > 0) {
#pragma unroll
            for (int j = 0; j < 4; ++j) { st_h4(hrow + 4 * lane + 256 * j, v[j]); v[j] = ld_h4(hrow + 4 * lane + 256 * j); }
        }
        float ss = 0.f;
#pragma unroll
        for (int j = 0; j < 4; ++j) ss += (v[j][0] * v[j][0] + v[j][1] * v[j][1]) + (v[j][2] * v[j][2] + v[j][3] * v[j][3]);
        ss = 1.0f / sqrtf(wave_sum(ss) * (1.f / DM) + EPS);
        const float* sh = modl + (size_t)4 * NMODC + shidx * DM; const float* sc = sh + DM;
#pragma unroll
        for (int j = 0; j < 4; ++j) { const f32x4 s1 = *(const f32x4*)(sc + 4 * lane + 256 * j), s0 = *(const f32x4*)(sh + 4 * lane + 256 * j), gv = *(const f32x4*)(gvec + 4 * lane + 256 * j);
            const f32x4 o = (v[j] * ss) * (gv * (s1 + 1.0f)) + s0;
            u32x2 w; w.x = pk2(o[0], o[1]); w.y = pk2(o[2], o[3]);
            *(u32x2*)(U + (size_t)(ML + cr) * DM + 4 * lane + 256 * j) = w; }
    }
}
__device__ __forceinline__ void final_phase(const Ctx& a, int G, const float* gvec) {
    const int lane = lane_now(), wave = a.wv;
    const int gw = blockIdx.x * 8 + wave, NGW = G * 8;
    const bf16_t* HF = (const bf16_t*)(a.ws + WS_BR);
    for (int row0 = gw * 4; row0 < ML; row0 += NGW * 4) {
        f32x4 v[4][4]; float ss[4];
#pragma unroll
        for (int r = 0; r < 4; ++r) { ss[r] = 0.f;
#pragma unroll
            for (int j = 0; j < 4; ++j) { v[r][j] = ld_h4(HF + (size_t)(row0 + r) * DM + 4 * lane + 256 * j); ss[r] += (v[r][j][0] * v[r][j][0] + v[r][j][1] * v[r][j][1]) + (v[r][j][2] * v[r][j][2] + v[r][j][3] * v[r][j][3]); } }
#pragma unroll
        for (int r = 0; r < 4; ++r) ss[r] = 1.0f / sqrtf(wave_sum(ss[r]) * (1.f / DM) + EPS);
#pragma unroll
        for (int j = 0; j < 4; ++j) { const f32x4 gv = *(const f32x4*)(gvec + 4 * lane + 256 * j);
#pragma unroll
            for (int r = 0; r < 4; ++r) *(f32x4*)(a.out + (size_t)(row0 + r) * DM + 4 * lane + 256 * j) = v[r][j] * ss[r] * gv; }
    }
}

struct KV { bf16x8 ka0, ka1, kb0, kb1; u32x4 v[4]; };
struct Tile { float m, l; f32x4 o[4]; };
__device__ __forceinline__ void kv_load(KV& kv, const bf16_t* Kb, const bf16_t* Vb, int kt0, int kt1) {
    const bf16_t* K0 = Kb + (size_t)kt0 * PW; const bf16_t* K1 = Kb + (size_t)kt1 * PW;
    kv.ka0 = *(const bf16x8*)K0; kv.ka1 = *(const bf16x8*)(K0 + 32); kv.kb0 = *(const bf16x8*)K1; kv.kb1 = *(const bf16x8*)(K1 + 32);
#pragma unroll
    for (int db = 0; db < 4; ++db) { const u32x2 lo = *(const u32x2*)(Vb + (size_t)kt0 * 64 + db * 64), hi = *(const u32x2*)(Vb + (size_t)kt1 * 64 + db * 64); kv.v[db] = (u32x4){lo.x, lo.y, hi.x, hi.y}; }
}
__device__ __forceinline__ void tile_compute(Tile& st, const LAS bf16x8* qlds, const KV& kv, f32x4 b0, f32x4 b1, const int bp16, const int bp32) {
    const bf16x8 q0 = qlds[0], q1 = qlds[64];
    f32x4 s0 = __builtin_amdgcn_mfma_f32_16x16x32_bf16(kv.ka0, q0, b0, 0, 0, 0);
    s0 = __builtin_amdgcn_mfma_f32_16x16x32_bf16(kv.ka1, q1, s0, 0, 0, 0);
    f32x4 s1 = __builtin_amdgcn_mfma_f32_16x16x32_bf16(kv.kb0, q0, b1, 0, 0, 0);
    s1 = __builtin_amdgcn_mfma_f32_16x16x32_bf16(kv.kb1, q1, s1, 0, 0, 0);
    float mx = fmaxf(fmaxf(fmaxf(s0[0], s0[1]), fmaxf(s0[2], s0[3])), fmaxf(fmaxf(s1[0], s1[1]), fmaxf(s1[2], s1[3])));
    mx = fmaxf(mx, __builtin_bit_cast(float, __builtin_amdgcn_ds_bpermute(bp16, __builtin_bit_cast(int, mx))));
    mx = fmaxf(mx, __builtin_bit_cast(float, __builtin_amdgcn_ds_bpermute(bp32, __builtin_bit_cast(int, mx))));
    if (__builtin_amdgcn_ballot_w64(mx > st.m) != 0ull) {
        const float mn = fmaxf(st.m, mx); const float alpha = __builtin_amdgcn_exp2f(st.m - mn); st.l *= alpha; st.m = mn;
#pragma unroll
        for (int db = 0; db < 4; ++db) st.o[db] = st.o[db] * alpha; }
    const float mn = st.m;
    float p[8];
#pragma unroll
    for (int i = 0; i < 4; ++i) { p[i] = __builtin_amdgcn_exp2f(s0[i] - mn); p[4 + i] = __builtin_amdgcn_exp2f(s1[i] - mn); }
    st.l += ((p[0] + p[1]) + (p[2] + p[3])) + ((p[4] + p[5]) + (p[6] + p[7]));
    u32x4 pw; pw.x = pk2(p[0], p[1]); pw.y = pk2(p[2], p[3]); pw.z = pk2(p[4], p[5]); pw.w = pk2(p[6], p[7]);
    const bf16x8 pb = __builtin_bit_cast(bf16x8, pw);
#pragma unroll
    for (int db = 0; db < 4; ++db) st.o[db] = __builtin_amdgcn_mfma_f32_16x16x32_bf16(__builtin_bit_cast(bf16x8, kv.v[db]), pb, st.o[db], 0, 0, 0);
    __builtin_amdgcn_sched_barrier(0);
}

__device__ __forceinline__ void pair_compute(Tile (&T)[4], const LAS bf16x8* qlds, const KV& cur, const LAS float* btab, const int p, const int kind, const int h, const int r0, const int krlo,
                                             const int bs, const int qc, const int wsx, const int qt, const int qpos, const int g, const int bp16, const int bp32) {
    const f32x4 zero4 = (f32x4){0.f, 0.f, 0.f, 0.f};
    f32x4 bc0 = zero4, bc1 = zero4; bool anyv = true;
    int dca[4], dcb[4]; bool vla[4], vlb[4];
    const int kr = krlo + p - 8;
    const bool loc = p >= 8;
    if (loc) {
        if (kind == 0) {
#pragma unroll
            for (int i = 0; i < 4; ++i) { const int kca = bs + 4 * g + i, kcb = kca + 16;
                dca[i] = min(max(kca - qc, -15), 15) + 15; dcb[i] = min(max(kcb - qc, -15), 15) + 15;
                vla[i] = (kca >= wsx && kca < wsx + 16); vlb[i] = (kcb >= wsx && kcb < wsx + 16); }
        } else {
            const int kp0 = qt * 16 - 128 + 32 * (p - 8), kp1 = kp0 + 16;
            const bool v0 = kp0 >= 0 && kp0 < SEQ, v1 = (p - 8 < 8) && kp1 >= 0 && kp1 < SEQ;
#pragma unroll
            for (int i = 0; i < 4; ++i) { const int da = kp0 + 4 * g + i - qpos, db2 = kp1 + 4 * g + i - qpos;
                bc0[i] = (v0 && da >= -128 && da <= 128) ? 0.f : -1e30f; bc1[i] = (v1 && db2 >= -128 && db2 <= 128) ? 0.f : -1e30f; }
            anyv = v0 || v1;
        }
    }
    const bool na_loc = (kind == 0) && loc;
#pragma unroll
    for (int j = 0; j < 4; ++j) {
        bool act = anyv; f32x4 b0 = bc0, b1 = bc1;
        if (na_loc) { const int rj = r0 + j; const int rsj = min(max(rj - 4, 0), 56); act = (kr >= rsj && kr <= rsj + 7);
            if (act) { const LAS float* brow = btab + h * 465 + (kr - rj + 7) * 31;
#pragma unroll
                for (int i = 0; i < 4; ++i) { b0[i] = vla[i] ? brow[dca[i]] : -1e30f; b1[i] = vlb[i] ? brow[dcb[i]] : -1e30f; } } }
        if (act) tile_compute(T[j], qlds + j * 128, cur, b0, b1, bp16, bp32);
    }
}

__device__ __forceinline__ void attn_multi(const Ctx& a, LAS unsigned char* lds, const LAS float* btab, int layer, int kind, int id) {
    const int lane = lane_now(), fr = lane & 15, g = lane >> 4;
    const bf16_t* P = (const bf16_t*)(a.ws + WS_R1); const bf16_t* VT = (const bf16_t*)(a.ws + WS_VT); bf16_t* BR = (bf16_t*)(a.ws + WS_BR);
    const float* sinks = (const float*)(a.ws + WS_SM) + SM_SINK + layer * 8;
    int b, h = 0, q0b, q0s, qcb, qcs, kcol, vrow; bool has_sink = false;
    int r0 = 0, cb = 0, qt = 0, kvh = 0, np = 8;
    if (kind == 0) { cb = id & 3; r0 = ((id >> 2) & 15) * 4; h = (id >> 6) & 7; b = id >> 9; q0b = b * SEQ + r0 * 64 + cb * 16; q0s = 64; qcb = h * 64; qcs = 0; kcol = 512 + h * 64; vrow = h * 64; }
    else if (kind == 1) { qt = id & 255; kvh = (id >> 8) & 1; b = id >> 9; q0b = b * SEQ + qt * 16; q0s = 0; qcb = 1024 + kvh * 256; qcs = 64; kcol = 1536 + kvh * 64; vrow = 512 + kvh * 64; has_sink = true; np = 17; }
    else if (kind == 2) { const int qq = id & 3; h = (id >> 2) & 7; b = id >> 5; q0b = ML + b * CTXL + qq * 64; q0s = 16; qcb = h * 64; qcs = 0; kcol = 512 + h * 64; vrow = h * 64; }
    else { qt = id & 15; kvh = (id >> 4) & 1; b = id >> 5; q0b = ML + b * CTXL + qt * 16; q0s = 0; qcb = 1024 + kvh * 256; qcs = 64; kcol = 1536 + kvh * 64; vrow = 512 + kvh * 64; has_sink = true; }
    Tile T[4];
    LAS bf16x8* qlds = (LAS bf16x8*)(lds + a.wv * 8192) + lane;
#pragma unroll
    for (int j = 0; j < 4; ++j) { const bf16_t* qp = P + (size_t)(q0b + j * q0s + fr) * PW + qcb + j * qcs + 8 * g; { const u32x4 qa = *(const u32x4*)qp, qb = *(const u32x4*)(qp + 32); u32x4 sa, sb;
          sa.x = pk2(bflo(qa.x) * 0.18033688011112042f, bfhi(qa.x) * 0.18033688011112042f); sa.y = pk2(bflo(qa.y) * 0.18033688011112042f, bfhi(qa.y) * 0.18033688011112042f); sa.z = pk2(bflo(qa.z) * 0.18033688011112042f, bfhi(qa.z) * 0.18033688011112042f); sa.w = pk2(bflo(qa.w) * 0.18033688011112042f, bfhi(qa.w) * 0.18033688011112042f);
          sb.x = pk2(bflo(qb.x) * 0.18033688011112042f, bfhi(qb.x) * 0.18033688011112042f); sb.y = pk2(bflo(qb.y) * 0.18033688011112042f, bfhi(qb.y) * 0.18033688011112042f); sb.z = pk2(bflo(qb.z) * 0.18033688011112042f, bfhi(qb.z) * 0.18033688011112042f); sb.w = pk2(bflo(qb.w) * 0.18033688011112042f, bfhi(qb.w) * 0.18033688011112042f);
          qlds[j * 128] = __builtin_bit_cast(bf16x8, sa); qlds[j * 128 + 64] = __builtin_bit_cast(bf16x8, sb); }
        T[j].m = -1e30f; T[j].l = 0.f;
#pragma unroll
        for (int db = 0; db < 4; ++db) T[j].o[db] = (f32x4){0.f, 0.f, 0.f, 0.f}; }
    const bf16_t* Kb = P + (size_t)fr * PW + kcol + 8 * g;
    const bf16_t* Vb = VT + (size_t)(vrow >> 6) * ((size_t)MT * 64) + fr * 4 + g * 256;
    const int kc0 = ML + b * CTXL;
    const int krlo = min(max(r0 - 4, 0), 56), krhi = min(max(r0 + 3 - 4, 0), 56) + 7;
    const int bs = min(max(cb * 16 - 8, 0), 32); const int qc = cb * 16 + fr; const int wsx = min(max(qc - 8, 0), 48);
    if (kind == 0) np = 8 + (krhi - krlo + 1);
    const int qpos = qt * 16 + fr;
    const f32x4 zero4 = (f32x4){0.f, 0.f, 0.f, 0.f};
#define PAIR_KT(pp, kt0, kt1) do { if ((pp) < 8) { kt0 = kc0 + 32 * (pp); kt1 = kt0 + 16; } \
        else if (kind == 0) { kt0 = b * SEQ + (krlo + (pp) - 8) * 64 + bs; kt1 = kt0 + 16; } \
        else { const int kp0_ = qt * 16 - 128 + 32 * ((pp) - 8); kt0 = b * SEQ + min(max(kp0_, 0), SEQ - 16); kt1 = b * SEQ + min(max(kp0_ + 16, 0), SEQ - 16); } } while (0)
    const int bp16 = (lane ^ 16) * 4, bp32 = (lane ^ 32) * 4;
    KV ka, kb;
    kv_load(ka, Kb, Vb, kc0, kc0 + 16);
#pragma unroll 1
    for (int p = 0; p < np; p += 2) {
        if (p + 1 < np) { int kt0, kt1; PAIR_KT(p + 1, kt0, kt1); kv_load(kb, Kb, Vb, kt0, kt1); }
        pair_compute(T, qlds, ka, btab, p, kind, h, r0, krlo, bs, qc, wsx, qt, qpos, g, bp16, bp32);
        if (p + 1 < np) {
            if (p + 2 < np) { int kt0, kt1; PAIR_KT(p + 2, kt0, kt1); kv_load(ka, Kb, Vb, kt0, kt1); }
            pair_compute(T, qlds, kb, btab, p + 1, kind, h, r0, krlo, bs, qc, wsx, qt, qpos, g, bp16, bp32);
        }
    }
#undef PAIR_KT
#pragma unroll
    for (int j = 0; j < 4; ++j) {
        float lt = T[j].l; lt += __shfl_xor(lt, 16); lt += __shfl_xor(lt, 32);
        if (has_sink) lt += __builtin_amdgcn_exp2f(sinks[4 * kvh + j] * 1.4426950408889634f - T[j].m);
        const float inv = 1.0f / lt;
        bf16_t* op = BR + (size_t)(q0b + j * q0s + fr) * BRW + qcb + j * qcs + 4 * g;
#pragma unroll
        for (int db = 0; db < 4; ++db) { const f32x4 o = T[j].o[db] * inv; u32x2 w; w.x = pk2(o[0], o[1]); w.y = pk2(o[2], o[3]); *(u32x2*)(op + db * 16) = w; }
    }
}

__device__ __forceinline__ void fourier_unit(const Ctx& a, LAS unsigned char* lds, int unit) {
    const int lane = lane_now(), wave = a.wv, tid = wave * 64 + lane, fr = lane & 15, g = lane >> 4;
    const int b = unit >> 6, cg8 = unit & 63; const int cY = cg8 * 8 + wave;
    const bf16_t* YT = (const bf16_t*)(a.ws + WS_VT); bf16_t* BR = (bf16_t*)(a.ws + WS_BR);
    const bf16x8* FB1 = (const bf16x8*)(a.ws + WS_FB1); const bf16x8* A3 = (const bf16x8*)(a.ws + WS_A3); const float2* TW = (const float2*)(a.ws + WS_TW);
    LAS bf16_t* inp = (LAS bf16_t*)(lds + wave * 16384);
    LAS bf16_t* stg = (LAS bf16_t*)(lds + LDS_X + 15360);
    {
        const u32x4* s0 = (const u32x4*)(YT + (size_t)(768 + cY) * MT + (size_t)b * SEQ) + lane;
        const u32x4* s1 = (const u32x4*)(YT + (size_t)(1280 + cY) * MT + (size_t)b * SEQ) + lane;
        u32x4 v[8];
#pragma unroll
        for (int i = 0; i < 8; ++i) v[i] = s0[i * 64];
#pragma unroll
        for (int i = 0; i < 8; ++i) *(LAS u32x4*)(inp + (i * 64 + lane) * 8) = v[i];
#pragma unroll
        for (int i = 0; i < 8; ++i) v[i] = s1[i * 64];
#pragma unroll
        for (int i = 0; i < 8; ++i) *(LAS u32x4*)(inp + 4096 + (i * 64 + lane) * 8) = v[i];
    }
#pragma unroll 1
    for (int nt3 = 0; nt3 < 4; ++nt3) {
        bf16x8 fb[4][2];
#pragma unroll
        for (int ks = 0; ks < 4; ++ks) { fb[ks][0] = FB1[(ks * 8 + nt3) * 64 + lane]; fb[ks][1] = FB1[(ks * 8 + nt3 + 4) * 64 + lane]; }
        const bf16x8* A3p = A3; asm volatile("" : "+v"(A3p));
        bf16x8 a3[4][4];
#pragma unroll
        for (int m3 = 0; m3 < 4; ++m3)
#pragma unroll
            for (int ks3 = 0; ks3 < 4; ++ks3) a3[m3][ks3] = A3p[(m3 * 4 + ks3) * 64 + lane];
        f32x4 zr[4], zi[4];
#pragma unroll
        for (int mt = 0; mt < 4; ++mt) {
            zr[mt] = (f32x4){0.f, 0.f, 0.f, 0.f}; zi[mt] = (f32x4){0.f, 0.f, 0.f, 0.f};
#pragma unroll
            for (int ks = 0; ks < 4; ++ks) {
                const LAS bf16_t* src = inp + (ks >> 1) * 4096 + (32 * (ks & 1) + 8 * g) * 64 + 16 * mt + fr;
                bf16x8 A1;
#pragma unroll
                for (int j = 0; j < 8; ++j) A1[j] = (short)src[j * 64];
                zr[mt] = __builtin_amdgcn_mfma_f32_16x16x32_bf16(A1, fb[ks][0], zr[mt], 0, 0, 0);
                zi[mt] = __builtin_amdgcn_mfma_f32_16x16x32_bf16(A1, fb[ks][1], zi[mt], 0, 0, 0);
            }
        }
#pragma unroll
        for (int mt = 0; mt < 4; ++mt)
#pragma unroll
            for (int i = 0; i < 4; ++i) { const float2 cs = TW[(16 * mt + 4 * g + i) * 64 + 16 * nt3 + fr];
                const float r_ = zr[mt][i], i_ = zi[mt][i]; zr[mt][i] = r_ * cs.x + i_ * cs.y; zi[mt][i] = i_ * cs.x - r_ * cs.y; }
        bf16x8 B3[4];
        { u32x4 w;
          w.x = pk2(zr[0][0], zr[0][1]); w.y = pk2(zr[0][2], zr[0][3]); w.z = pk2(zr[1][0], zr[1][1]); w.w = pk2(zr[1][2], zr[1][3]); B3[0] = __builtin_bit_cast(bf16x8, w);
          w.x = pk2(zr[2][0], zr[2][1]); w.y = pk2(zr[2][2], zr[2][3]); w.z = pk2(zr[3][0], zr[3][1]); w.w = pk2(zr[3][2], zr[3][3]); B3[1] = __builtin_bit_cast(bf16x8, w);
          w.x = pk2(zi[0][0], zi[0][1]); w.y = pk2(zi[0][2], zi[0][3]); w.z = pk2(zi[1][0], zi[1][1]); w.w = pk2(zi[1][2], zi[1][3]); B3[2] = __builtin_bit_cast(bf16x8, w);
          w.x = pk2(zi[2][0], zi[2][1]); w.y = pk2(zi[2][2], zi[2][3]); w.z = pk2(zi[3][0], zi[3][1]); w.w = pk2(zi[3][2], zi[3][3]); B3[3] = __builtin_bit_cast(bf16x8, w); }
#pragma unroll
        for (int m3 = 0; m3 < 4; ++m3) {
            f32x4 o = (f32x4){0.f, 0.f, 0.f, 0.f};
#pragma unroll
            for (int ks3 = 0; ks3 < 4; ++ks3) o = __builtin_amdgcn_mfma_f32_16x16x32_bf16(a3[m3][ks3], B3[ks3], o, 0, 0, 0);
#pragma unroll
            for (int i = 0; i < 4; ++i) { const int n2p = 16 * m3 + 4 * g + i; stg[(n2p * 16 + fr) * 8 + wave] = (bf16_t)f2bf(o[i]); }
        }
        __syncthreads();
        for (int e = tid; e < 1024; e += 512) { const int n2p = e >> 4, f = e & 15; const int tok = 16 * nt3 + f + 64 * n2p;
            const u32x4 v = *(const LAS u32x4*)(stg + e * 8); *(u32x4*)(BR + (size_t)(b * SEQ + tok) * BRW + 512 + cg8 * 8) = v; }
        __syncthreads();
    }
}

__device__ __forceinline__ void mix_phase(const Ctx& a, LAS unsigned char* lds, int G, int layer) {
    const int lane = lane_now(), wave = a.wv, tid = wave * 64 + lane;
    const int gw = blockIdx.x * 8 + wave, NGW = G * 8;
    LAS float* btab = (LAS float*)(lds + LDS_X);
    { const float* src = (const float*)(a.ws + WS_SM) + SM_BIAS + layer * 3720; for (int e = tid; e < 3720; e += 512) btab[e] = src[e] * 1.4426950408889634f; }
    for (int u = blockIdx.x; u < 256; u += G) fourier_unit(a, lds, u);
    LAS float* t256 = (LAS float*)(lds + 65536);
    if (layer == 0) { if (tid < 256) { float s, c; sincos_turns((double)tid / 256.0, s, c); t256[tid] = c; t256[256 + tid] = s; } }
    __syncthreads();
    const int n_c = (layer == 0) ? 128 : 0;
    const int total = 4096 + 2 * n_c;
    for (int id = gw; id < total; id += NGW) {
        int kind, uid;
        if (id < 2048) { kind = 0; uid = id; } else if (id < 4096) { kind = 1; uid = id - 2048; } else if (id < 4096 + n_c) { kind = 2; uid = id - 4096; } else { kind = 3; uid = id - 4096 - n_c; }
        attn_multi(a, lds, btab, layer, kind, uid);
    }
    if (layer == 0) {
        const bf16_t* YT = (const bf16_t*)(a.ws + WS_VT); bf16_t* BR = (bf16_t*)(a.ws + WS_BR);
        for (int it = gw; it < 4 * 512 * 4; it += NGW) {
            const int q = it & 3, cp = (it >> 2) & 511, b = it >> 11; const int np = 64 * q + lane;
            const u32x4* yr = (const u32x4*)(YT + (size_t)(768 + cp) * MT + ML + b * CTXL); const u32x4* yi = (const u32x4*)(YT + (size_t)(1280 + cp) * MT + ML + b * CTXL);
            float acc = 0.f;
#pragma unroll 2
            for (int n8 = 0; n8 < 32; ++n8) { const u32x4 r = yr[n8], im = yi[n8];
                const unsigned rw[4] = {r.x, r.y, r.z, r.w}, iw[4] = {im.x, im.y, im.z, im.w};
#pragma unroll
                for (int e = 0; e < 4; ++e) { const int n = 8 * n8 + 2 * e; const int i0 = (n * np) & 255, i1 = ((n + 1) * np) & 255;
                    acc += t256[i0] * bflo(rw[e]) + t256[256 + i0] * bflo(iw[e]); acc += t256[i1] * bfhi(rw[e]) + t256[256 + i1] * bfhi(iw[e]); } }
            BR[(size_t)(ML + b * CTXL + np) * BRW + 512 + cp] = (bf16_t)f2bf(acc * (1.f / 16.f));
        }
    }
}

constexpr int N_PHASES = 25;
template <int L>
__device__ __forceinline__ void layer_phases(const Ctx& cx, const XcdBarrier& xb, LAS unsigned char* lds, const int G, const int c, const int lo, const int hi) {
    unsigned char* ws = cx.ws;
    bf16_t* HL = h_lat(cx); bf16_t* HCx = (bf16_t*)(ws + WS_HC);
    const float* mod = (const float*)(ws + WS_MOD);
    const float* sm = (const float*)(ws + WS_SM);
    constexpr bool last = (L == 1);
    const unsigned char* wl = ws + WS_W + (size_t)L * WS_WL;
    const float* modl = mod + (size_t)L * 5 * NMODC;
    constexpr int Mfull = MT, Mlat = last ? ML : MT;
    constexpr int P0 = 1 + 12 * L;
#define IN(k) (lo <= (k) && (k) < hi)
#define SEAM(k) do { if (IN(k) && IN((k) + 1)) xcd_barrier(xb); } while (0)
    if (IN(P0 + 0)) { if (L == 0) norm_phase<1>(cx, G, MT, sm + SM_GF1 + L * DM, modl, 0); else norm_phase<0, 11>(cx, G, MT, sm + SM_GF1 + L * DM, modl, 0, mod + 4 * NMODC + 8 * DM, 0.5f); }
    SEAM(P0 + 0);
    if (IN(P0 + 1)) {
        pg8::Sched2 S{}; S.G = G; S.c = c; S.nM0 = Mfull / 256; S.nN0 = 22; S.n0 = S.nM0 * S.nN0; S.A0 = (const char*)(ws + WS_U); S.B0 = (const char*)(wl + WO_13A);
        S.at0 = (size_t)256 * DM * 2; S.bt0 = (size_t)256 * DM * 2; S.n1 = 0;
        pg8::EpiUp E{(bf16_t*)(ws + WS_R1)};
        if ((NULLMASK >> (P0 + 1)) & 1u) { pg8::EpiNullP E0{(float*)(ws + 32768)}; pg8::gemm_phase(cx.wv, lds, DM, DM, DM, S, E0); }
        pg8::gemm_phase(cx.wv, lds, DM, DM, DM, S, E); if ((REPMASK >> (P0 + 1)) & 1u) { xcd_barrier(xb); pg8::gemm_phase(cx.wv, lds, DM, DM, DM, S, E); } }
    SEAM(P0 + 1);
    if (IN(P0 + 2)) {
        { pg8::Sched2 S{}; S.G = G; S.c = c; S.nM0 = ML / 256; S.nN0 = 4; S.n0 = S.nM0 * S.nN0; S.A0 = (const char*)(ws + WS_R1); S.B0 = (const char*)(wl + WO_2A);
          S.at0 = (size_t)256 * DFF * 2; S.bt0 = (size_t)256 * DFF * 2; S.n1 = 0;
          pg8::EpiRes E{HL, HCx, modl + 2 * DM, 0.5f, HL};
          if ((NULLMASK >> (P0 + 2)) & 1u) { pg8::EpiNull E0{(float*)(ws + 32768)}; pg8::gemm_phase(cx.wv, lds, DFF, DFF, DFF, S, E0); }
          pg8::gemm_phase(cx.wv, lds, DFF, DFF, DFF, S, E); }
        { pg8::SchedSplit S{G, c, 11, (const char*)(ws + WS_R1) + (size_t)ML * DFF * 2, (const char*)(wl + WO_2A), (size_t)DFF * 2, (size_t)DFF * 2, 11, 0};
          pg8::EpiPart E{(float*)(ws + WS_BR)};
          pg8::gemm_phase(cx.wv, lds, 256, DFF, DFF, S, E); } }
    SEAM(P0 + 2);
    if (IN(P0 + 3)) norm_phase<0, 11>(cx, G, MT, sm + SM_GMIX + L * DM, modl, 3, modl + 4 * NMODC + 2 * DM, 0.5f);
    SEAM(P0 + 3);
    if (IN(P0 + 4)) {
        pg8::Sched2 S{}; S.G = G; S.c = c;
        S.nM0 = MT / 256; S.nN0 = 7; S.n0 = S.nM0 * S.nN0; S.A0 = (const char*)(ws + WS_U); S.B0 = (const char*)(wl + WO_IN); S.at0 = (size_t)256 * DM * 2; S.bt0 = (size_t)256 * DM * 2;
        S.nM1 = 7; S.nN1 = MT / 256; S.n1 = S.nM1 * S.nN1; S.A1 = (const char*)(wl + WO_INT); S.B1 = (const char*)(ws + WS_U); S.at1 = (size_t)256 * DM * 2; S.bt1 = (size_t)256 * DM * 2;
        pg8::EpiWin E{(bf16_t*)(ws + WS_R1), (bf16_t*)(ws + WS_VT), (const float*)(ws + WS_ROPE)};
        pg8::gemm_phase(cx.wv, lds, DM, DM, DM, S, E); if ((REPMASK >> (P0 + 4)) & 1u) { xcd_barrier(xb); pg8::gemm_phase(cx.wv, lds, DM, DM, DM, S, E); } }
    SEAM(P0 + 4);
    if (IN(P0 + 5)) { mix_phase(cx, lds, G, L); if ((REPMASK >> (P0 + 5)) & 1u) { xcd_barrier(xb); mix_phase(cx, lds, G, L); } }
    SEAM(P0 + 5);
    if (IN(P0 + 6)) {
        pg8::Sched2 S{}; S.G = G; S.c = c; S.nM0 = Mlat / 256; S.nN0 = 12; S.n0 = S.nM0 * S.nN0; S.A0 = (const char*)(ws + WS_U); S.B0 = (const char*)(wl + WO_G);
        S.at0 = (size_t)256 * DM * 2; S.bt0 = (size_t)256 * DM * 2; S.n1 = 0;
        pg8::EpiGate E{(bf16_t*)(ws + WS_R1)};
        pg8::gemm_phase(cx.wv, lds, DM, DM, DM, S, E); if ((REPMASK >> (P0 + 6)) & 1u) { xcd_barrier(xb); pg8::gemm_phase(cx.wv, lds, DM, DM, DM, S, E); } }
    SEAM(P0 + 6);
    if (IN(P0 + 7)) {
        { pg8::SchedMerge S{G, c, ML / 256, (const char*)(ws + WS_BR), (const char*)(wl + WO_BR)};
          pg8::EpiMerge E{(const bf16_t*)(ws + WS_R1), (bf16_t*)(ws + WS_U), nullptr};
          pg8::gemm_phase(cx.wv, lds, 512, BRW, 512, S, E); }
        if (!last) { pg8::SchedMergeCtx S{G, c, (const char*)(ws + WS_BR), (const char*)(wl + WO_BR)};
          pg8::EpiMerge E{(const bf16_t*)(ws + WS_R1), (bf16_t*)(ws + WS_U), (bf16_t*)cx.out};
          pg8::gemm_phase(cx.wv, lds, 512, BRW, 512, S, E); } }
    SEAM(P0 + 7);
    if (IN(P0 + 8)) {
        { pg8::Sched2 S{}; S.G = G; S.c = c; S.nM0 = ML / 256; S.nN0 = 4; S.n0 = S.nM0 * S.nN0; S.A0 = (const char*)(ws + WS_U); S.B0 = (const char*)(wl + WO_OUT);
          S.at0 = (size_t)256 * DM * 2; S.bt0 = (size_t)256 * DM * 2; S.n1 = 0;
          pg8::EpiRes E{HL, HCx, modl + 5 * DM, 1.0f, last ? (bf16_t*)(ws + WS_BR) : HL};
          pg8::gemm_phase(cx.wv, lds, DM, DM, DM, S, E); }
        if (!last) { pg8::SchedSplit S{G, c, 12, (const char*)cx.out, (const char*)(wl + WO_OUT), (size_t)DM * 2, (size_t)DM * 2, 4, (size_t)MC * DM * 2};
          pg8::EpiPart E{(float*)(ws + WS_BR)};
          pg8::gemm_phase(cx.wv, lds, 256, DM, DM, S, E); } }
    SEAM(P0 + 8);
    if (IN(P0 + 9)) { if (last) norm_phase<0>(cx, G, Mlat, sm + SM_GF2 + L * DM, modl, 6, nullptr, 0.f, (bf16_t*)(ws + WS_BR)); else norm_phase<0, 12>(cx, G, Mlat, sm + SM_GF2 + L * DM, modl, 6, modl + 4 * NMODC + 5 * DM, 1.0f); }
    SEAM(P0 + 9);
    if (IN(P0 + 10)) {
        pg8::Sched2 S{}; S.G = G; S.c = c; S.nM0 = Mlat / 256; S.nN0 = 22; S.n0 = S.nM0 * S.nN0; S.A0 = (const char*)(ws + WS_U); S.B0 = (const char*)(wl + WO_13B);
        S.at0 = (size_t)256 * DM * 2; S.bt0 = (size_t)256 * DM * 2; S.n1 = 0;
        pg8::EpiUp E{(bf16_t*)(ws + WS_R1)};
        pg8::gemm_phase(cx.wv, lds, DM, DM, DM, S, E); if ((REPMASK >> (P0 + 10)) & 1u) { xcd_barrier(xb); pg8::gemm_phase(cx.wv, lds, DM, DM, DM, S, E); } }
    SEAM(P0 + 10);
    if (IN(P0 + 11)) {
        pg8::Sched2 S{}; S.G = G; S.c = c; S.nM0 = ML / 256; S.nN0 = 4; S.n0 = S.nM0 * S.nN0; S.A0 = (const char*)(ws + WS_R1); S.B0 = (const char*)(wl + WO_2B);
        S.at0 = (size_t)256 * DFF * 2; S.bt0 = (size_t)256 * DFF * 2; S.n1 = 0;
        if (last) {
            pg8::EpiFinal E{ws, cx.out};
            pg8::gemm_phase(cx.wv, lds, DFF, DFF, DFF, S, E);
        } else {
            { pg8::EpiRes E{HL, HCx, modl + 8 * DM, 0.5f, HL};
              pg8::gemm_phase(cx.wv, lds, DFF, DFF, DFF, S, E); }
            { pg8::SchedSplit S2{G, c, 11, (const char*)(ws + WS_R1) + (size_t)ML * DFF * 2, (const char*)(wl + WO_2B), (size_t)DFF * 2, (size_t)DFF * 2, 11, 0};
              pg8::EpiPart E{(float*)(ws + WS_BR)};
              pg8::gemm_phase(cx.wv, lds, 256, DFF, DFF, S2, E); } } }
    SEAM(P0 + 11);
#undef IN
#undef SEAM
}

__global__ void __launch_bounds__(512, 2) mk_fwd(Args a) {
    extern __shared__ __attribute__((aligned(16))) unsigned char lds_raw[];
    LAS unsigned char* lds = (LAS unsigned char*)lds_raw;
    const int G = gridDim.x, c = blockIdx.x;
    const int lo = a.ph_lo, hi = a.ph_hi;
    volatile LAS unsigned* xst = (volatile LAS unsigned*)(lds + LDS_BYTES - 64);
    const int wv = __builtin_amdgcn_readfirstlane((int)(threadIdx.x >> 6));
    { const int l0 = lane_now(); if (wv == 0 && l0 < 2) xst[l0] = 0u; }
    __syncthreads();
    XcdBarrier xb = xcd_barrier_post((unsigned*)a.ws, xst, wv);
    if (hi > 0x7fff0000) cg::this_grid().sync();
    if (lo == 0) { prep_phase(a, wv, lds, G); if (REPMASK & 1u) { xcd_barrier(xb); prep_phase(a, wv, lds, G); } if (hi > 1) xcd_barrier(xb); }
    Ctx cx; cx.out = a.out; cx.ws = a.ws; cx.x = a.x; cx.ctx = a.ctx; cx.wv = wv;
    layer_phases<0>(cx, xb, lds, G, c, lo, hi);
    layer_phases<1>(cx, xb, lds, G, c, lo, hi);

}

extern "C" void kernel_launch(void* const* d_in, const int* in_sizes, int n_in, void* d_out, int out_size, void* d_ws, size_t ws_size, hipStream_t stream) {
    static int grid = 0;
    if (grid == 0) {
        if (n_in != 19 || out_size != ML * DM || ws_size < WS_END) { fprintf(stderr, "kernel_launch: unexpected shapes: n_in %d out %d ws %zu (need %zu)\n", n_in, out_size, ws_size, (size_t)WS_END); grid = -1; return; }
        int dev = 0, cus = 0, per_cu = 0;
        (void)hipGetDevice(&dev); (void)hipDeviceGetAttribute(&cus, hipDeviceAttributeMultiprocessorCount, dev);
        if (hipFuncSetAttribute((const void*)mk_fwd, hipFuncAttributeMaxDynamicSharedMemorySize, LDS_BYTES) != hipSuccess) { fprintf(stderr, "kernel_launch: hipFuncSetAttribute failed\n"); grid = -1; return; }
        if (hipOccupancyMaxActiveBlocksPerMultiprocessor(&per_cu, (const void*)mk_fwd, 512, LDS_BYTES) != hipSuccess || per_cu < 1) { fprintf(stderr, "kernel_launch: occupancy query says %d\n", per_cu); per_cu = 1; }
        (void)hipGetLastError();
        grid = cus * per_cu;
        fprintf(stderr, "kernel_launch: grid %d (cus %d per_cu %d) ws %zu\n", grid, cus, per_cu, ws_size);
    }
    if (grid < 0) return;
    Args a{};
    a.x = (const float*)d_in[0]; a.c = (const float*)d_in[1]; a.ctx = (const float*)d_in[2]; a.c_ctx = (const float*)d_in[3]; a.w_ada = (const float*)d_in[4]; a.b_ada = (const float*)d_in[5];
    a.g_ffn1 = (const float*)d_in[6]; a.ffn1_w13 = (const float*)d_in[7]; a.ffn1_w2 = (const float*)d_in[8]; a.g_mix = (const float*)d_in[9]; a.w_in = (const float*)d_in[10];
    a.na_bias = (const float*)d_in[11]; a.wa_sink = (const float*)d_in[12]; a.w_br = (const float*)d_in[13]; a.w_out = (const float*)d_in[14]; a.g_ffn2 = (const float*)d_in[15];
    a.ffn2_w13 = (const float*)d_in[16]; a.ffn2_w2 = (const float*)d_in[17]; a.g_final = (const float*)d_in[18];
    a.out = (float*)d_out; a.ws = (unsigned char*)d_ws;
    (void)hipMemsetAsync(d_ws, 0, 16384, stream);
#if MK_MULTI
    for (int ph = 0; ph < N_PHASES; ++ph) { a.ph_lo = ph; a.ph_hi = ph + 1; hipLaunchKernelGGL(mk_fwd, dim3(grid), dim3(512), LDS_BYTES, stream, a); }
#else
    a.ph_lo = 0; a.ph_hi = N_PHASES;
    void* args[] = {&a};
    hipError_t e = hipLaunchCooperativeKernel((const void*)mk_fwd, dim3(grid), dim3(512), args, LDS_BYTES, stream);
    if (e != hipSuccess) fprintf(stderr, "cooperative launch failed: %s (grid %d)\n", hipGetErrorString(e), grid);
#endif
}
```

```cpp
#include <hip/hip_runtime.h>
#include <hip/hip_cooperative_groups.h>
#include <cstdio>
#include <cstdint>
namespace cg = cooperative_groups;

#ifndef MK_MULTI
#define MK_MULTI 0
#endif

#ifndef NULLMASK
#define NULLMASK 0u
#endif
#ifndef REPMASK
#define REPMASK 0u
#endif
#define LAS __attribute__((address_space(3)))
typedef unsigned short bf16_t;
typedef short bf16x8 __attribute__((ext_vector_type(8)));
typedef short s16x4 __attribute__((ext_vector_type(4)));
typedef float f32x4 __attribute__((ext_vector_type(4)));
typedef float f32x2 __attribute__((ext_vector_type(2)));
typedef unsigned u32x4 __attribute__((ext_vector_type(4)));
typedef unsigned u32x2 __attribute__((ext_vector_type(2)));

constexpr int DM = 1024, NBATCH = 4, SEQ = 4096, ML = NBATCH * SEQ, CTXL = 256, MC = NBATCH * CTXL, MT = ML + MC;
constexpr int DFF = 2816, PIN = 5888, NMODC = 9 * DM;
constexpr int PW = 1792;
constexpr int VTR = 1792;
constexpr int BRW = 1536;
constexpr int GLW = 3072;
constexpr float EPS = 1e-6f;

constexpr size_t MiB = 1u << 20;
constexpr size_t WS_MOD = 64 * 1024;
constexpr size_t WS_ROPE = 512 * 1024;
constexpr size_t WS_TW = 640 * 1024;
constexpr size_t WS_FB1 = 768 * 1024;
constexpr size_t WS_A3 = 896 * 1024;
constexpr size_t WS_SM = 1 * MiB;
constexpr int SM_GF1 = 0, SM_GMIX = 2048, SM_GF2 = 4096, SM_GFIN = 6144, SM_SINK = 7168, SM_BIAS = 7232, SM_END = 7232 + 7440;
constexpr size_t WS_RSQ = 1 * MiB + 128 * 1024;
constexpr size_t WS_CNT = 1 * MiB + 640 * 1024;
constexpr size_t WS_W = 2 * MiB, WS_WL = 52 * MiB;
constexpr size_t WO_13A = 0, WO_2A = 11 * MiB, WO_IN = WO_2A + 11 * MiB / 2, WO_INT = WO_IN + 7 * MiB / 2, WO_G = WO_INT + 7 * MiB / 2,
                 WO_BR = WO_G + 6 * MiB, WO_OUT = WO_BR + 3 * MiB, WO_13B = WO_OUT + 2 * MiB, WO_2B = WO_13B + 11 * MiB;
static_assert(WO_2B + 11 * MiB / 2 <= WS_WL, "weights");
constexpr size_t WS_HC = 106 * MiB;
constexpr size_t WS_U = 110 * MiB;
constexpr size_t WS_BR = 144 * MiB;
constexpr size_t WS_R1 = 195 * MiB;
constexpr size_t WS_VT = WS_R1 + (size_t)MT * PW * 2;
constexpr size_t WS_XB = WS_R1 + 119 * MiB;
constexpr size_t WS_END = WS_XB + 2 * MiB;
static_assert((size_t)MT * GLW * 2 <= 119 * MiB && (size_t)MT * DFF * 2 <= 119 * MiB && (size_t)MT * PW * 4 <= 119 * MiB, "R1");

constexpr int LDS_BYTES = 163840;
constexpr int LDS_X = 131072;

__device__ __forceinline__ int lane_now() { int l; asm volatile("v_mbcnt_lo_u32_b32 %0, -1, 0\n\tv_mbcnt_hi_u32_b32 %0, -1, %0" : "=v"(l)); return l; }
__device__ __forceinline__ unsigned f2bf(float f) { unsigned u = __builtin_bit_cast(unsigned, f); return (u + 0x7fffu + ((u >> 16) & 1u)) >> 16; }
typedef __bf16 bf16x2_t __attribute__((ext_vector_type(2)));
__device__ __forceinline__ unsigned pk2(float lo, float hi) { const f32x2 v = {lo, hi}; const bf16x2_t b = __builtin_convertvector(v, bf16x2_t); return __builtin_bit_cast(unsigned, b); }
__device__ __forceinline__ float bf2f(unsigned short b) { return __builtin_bit_cast(float, (unsigned)b << 16); }
__device__ __forceinline__ float bflo(unsigned w) { return __builtin_bit_cast(float, w << 16); }
__device__ __forceinline__ float bfhi(unsigned w) { return __builtin_bit_cast(float, w & 0xffff0000u); }
__device__ __forceinline__ float wave_sum(float v) {
#pragma unroll
    for (int o = 1; o < 64; o <<= 1) v += __shfl_xor(v, o);
    return v;
}
__device__ __forceinline__ void sincos_turns(double t, float& s, float& c) {
    const double k = __builtin_rint(t * 4.0); const double r = (t - k * 0.25) * 6.283185307179586476925;
    const double r2 = r * r;
    const double sp = r * (1.0 + r2 * (-1.0 / 6 + r2 * (1.0 / 120 + r2 * (-1.0 / 5040 + r2 * (1.0 / 362880 + r2 * (-1.0 / 39916800 + r2 * (1.0 / 6227020800.0)))))));
    const double cp = 1.0 + r2 * (-0.5 + r2 * (1.0 / 24 + r2 * (-1.0 / 720 + r2 * (1.0 / 40320 + r2 * (-1.0 / 3628800 + r2 * (1.0 / 479001600.0 + r2 * (-1.0 / 87178291200.0)))))));
    const int q = ((int)k) & 3;
    const double ss = (q == 0) ? sp : (q == 1) ? cp : (q == 2) ? -sp : -cp;
    const double cc = (q == 0) ? cp : (q == 1) ? -sp : (q == 2) ? -cp : sp;
    s = (float)ss; c = (float)cc;
}

namespace pg8 {
constexpr int BM = 256, BK = 64, HALF = 128, HTB = HALF * BK * 2, STAGE_BYTES = 8 * HTB, NXCD = 8, WGM = 8;
__device__ __forceinline__ int lds_byte(int r, int c) { const int st = (r >> 4) * 2 + (c >> 5), rr = r & 15, cc = c & 31, ob = rr * 64 + cc * 2; return st * 1024 + (ob ^ (((ob >> 9) & 1) << 5)); }
__device__ __forceinline__ void stage_rc(int b, int& R, int& C) { const int st = b / 1024, sb = b % 1024, swz = sb ^ (((sb >> 9) & 1) << 5); R = (st >> 1) * 16 + swz / 64; C = (st & 1) * 32 + (swz % 64) / 2; }
__device__ __forceinline__ int perm32(int rho) { const int n = rho >> 4, i = rho & 15; return 8 * (i >> 2) + 4 * n + (i & 3); }

struct Unit { int pm, pn, kind; const char* A; const char* B; };

__device__ __forceinline__ void tile_map(int L, int nM, int nN, int& pm, int& pn) {
    const int nwg = nM * nN; int wgid = L;
    { const int q = nwg / NXCD, r = nwg % NXCD, xcd = wgid % NXCD, off = wgid / NXCD; wgid = (xcd < r ? xcd * (q + 1) : r * (q + 1) + (xcd - r) * q) + off; }
    const int nig = WGM * nN, gid = wgid / nig, fm = gid * WGM, gsz = (nM - fm) < WGM ? (nM - fm) : WGM;
    pm = fm + ((wgid % nig) % gsz); pn = (wgid % nig) / gsz;
}

template <class Epi, class Sched>
__device__ __forceinline__ void gemm_phase(const int wv_, LAS unsigned char* lds, const int K, const int lda, const int ldb, const Sched& S, const Epi& E) {
    const int lane = lane_now(), wid = wv_, tid = wid * 64 + lane, wr = wid >> 2, wc = wid & 3, fr = lane & 15, fq = lane >> 4;
    const int nt = K / BK;
    unsigned voffA[2], voffB[2];
#pragma unroll
    for (int i = 0; i < 2; ++i) { int R, C; stage_rc(tid * 16 + i * 8192, R, C); const int Rb = Epi::PERM ? ((R & ~31) + perm32(R & 31)) : R;
        voffA[i] = (unsigned)(R * lda + C) * 2u; voffB[i] = (unsigned)(Rb * ldb + C) * 2u; }
    const size_t kstep = (size_t)(BK * 2);
    const size_t hstepA = (size_t)HALF * lda * 2, hstepB = (size_t)HALF * ldb * 2;
    const unsigned ldsw = (unsigned)wid * 1024u;
    const int aoff = lds_byte(wr * 64 + fr, fq * 8), boff = lds_byte(wc * 32 + fr, fq * 8);
#define PG8_SA(b, h) (((b) * 2 + (h)) * HTB)
#define PG8_SB(b, h) ((4 + (b) * 2 + (h)) * HTB)
#define PG8_STAGE(bufoff, gbase, voff) do { _Pragma("unroll") for (int _i = 0; _i < 2; ++_i) \
        __builtin_amdgcn_global_load_lds((const unsigned*)((const char*)(gbase) + (voff)[_i]), (LAS unsigned*)(lds + (bufoff) + ldsw + _i * 8192), 16, 0, 0); } while (0)
#define PG8_LDA(dst, b, h) do { _Pragma("unroll") for (int m = 0; m < 4; ++m) _Pragma("unroll") for (int k = 0; k < 2; ++k) dst[m][k] = *(const LAS bf16x8*)(lds + PG8_SA(b, h) + aoff + m * 2048 + k * 1024); } while (0)
#define PG8_LDB(dst, b, h) do { _Pragma("unroll") for (int n = 0; n < 2; ++n) _Pragma("unroll") for (int k = 0; k < 2; ++k) dst[n][k] = *(const LAS bf16x8*)(lds + PG8_SB(b, h) + boff + n * 2048 + k * 1024); } while (0)
#define PG8_MMA(ai, bj, At, Bt) do { __builtin_amdgcn_s_setprio(1); _Pragma("unroll") for (int m = 0; m < 4; ++m) _Pragma("unroll") for (int n = 0; n < 2; ++n) _Pragma("unroll") for (int k = 0; k < 2; ++k) \
        acc[ai][bj][m][n] = __builtin_amdgcn_mfma_f32_16x16x32_bf16(Bt[n][k], At[m][k], acc[ai][bj][m][n], 0, 0, 0); __builtin_amdgcn_s_setprio(0); } while (0)
#define PG8_WAIT_V(n) asm volatile("s_waitcnt vmcnt(" #n ")" ::: "memory")
#define PG8_WAIT_L(n) asm volatile("s_waitcnt lgkmcnt(" #n ")" ::: "memory")
#define PG8_BAR __builtin_amdgcn_s_barrier()
#define PG8_SCHED __builtin_amdgcn_sched_barrier(0)
    Unit cur, nxt; int ui = 0;
    if (!S.next(0, cur)) return;
    f32x4 acc[2][2][4][2];
#pragma unroll
    for (int a = 0; a < 2; ++a)
#pragma unroll
        for (int b = 0; b < 2; ++b)
#pragma unroll
            for (int m = 0; m < 4; ++m)
#pragma unroll
                for (int n = 0; n < 2; ++n) acc[a][b][m][n] = (f32x4){0.f, 0.f, 0.f, 0.f};
    bf16x8 At[4][2], B0[2][2], B1[2][2];
    const char* cA = cur.A; const char* cB = cur.B;
    PG8_STAGE(PG8_SB(0, 0), cB, voffB); PG8_STAGE(PG8_SB(0, 1), cB + hstepB, voffB); PG8_STAGE(PG8_SA(0, 0), cA, voffA); PG8_STAGE(PG8_SA(0, 1), cA + hstepA, voffA);
    if (wr == 1) PG8_BAR;
    PG8_WAIT_V(2); PG8_BAR;
    PG8_STAGE(PG8_SB(1, 0), cB + kstep, voffB); PG8_STAGE(PG8_SA(1, 0), cA + kstep, voffA); PG8_STAGE(PG8_SB(1, 1), cB + hstepB + kstep, voffB);
    PG8_WAIT_V(6); PG8_BAR;
    for (;;) {
        const bool has_next = S.next(ui + 1, nxt);
        const char* nA = has_next ? nxt.A : cA; const char* nB = has_next ? nxt.B : cB;
        for (int t = 0; t < nt; t += 2) {
            const bool last = (t == nt - 2);
            const char* a1 = cA + (size_t)(t + 1) * kstep;
            const char* a2 = last ? nA : cA + (size_t)(t + 2) * kstep; const char* b2 = last ? nB : cB + (size_t)(t + 2) * kstep;
            const char* a3 = a2 + kstep; const char* b3 = b2 + kstep;
            PG8_LDB(B0, 0, 0); PG8_LDB(B1, 0, 1); PG8_SCHED; PG8_LDA(At, 0, 0); PG8_STAGE(PG8_SA(1, 1), a1 + hstepA, voffA);
            PG8_WAIT_V(8); PG8_WAIT_L(0); PG8_BAR; PG8_MMA(0, 0, At, B0); PG8_MMA(0, 1, At, B1); PG8_BAR; PG8_SCHED;
            PG8_LDA(At, 0, 1); PG8_STAGE(PG8_SB(0, 0), b2, voffB); PG8_STAGE(PG8_SB(0, 1), b2 + hstepB, voffB); PG8_STAGE(PG8_SA(0, 0), a2, voffA);
            PG8_WAIT_V(8); PG8_WAIT_L(0); PG8_BAR; PG8_MMA(1, 0, At, B0); PG8_MMA(1, 1, At, B1); PG8_BAR; PG8_SCHED;
            PG8_LDB(B0, 1, 0); PG8_LDB(B1, 1, 1); PG8_SCHED; PG8_LDA(At, 1, 0); PG8_STAGE(PG8_SA(0, 1), a2 + hstepA, voffA);
            PG8_WAIT_V(8); PG8_WAIT_L(0); PG8_BAR; PG8_MMA(0, 0, At, B0); PG8_MMA(0, 1, At, B1); PG8_BAR; PG8_SCHED;
            PG8_LDA(At, 1, 1); PG8_STAGE(PG8_SB(1, 0), b3, voffB); PG8_STAGE(PG8_SB(1, 1), b3 + hstepB, voffB); PG8_STAGE(PG8_SA(1, 0), a3, voffA);
            PG8_WAIT_V(8); PG8_WAIT_L(0); PG8_BAR; PG8_MMA(1, 0, At, B0); PG8_MMA(1, 1, At, B1); PG8_BAR; PG8_SCHED;
        }
        if (wr == 0) PG8_BAR;
        E(acc, cur, wr, wc, fr, fq);
        if (!has_next) break;
#pragma unroll
        for (int a = 0; a < 2; ++a)
#pragma unroll
            for (int b = 0; b < 2; ++b)
#pragma unroll
                for (int m = 0; m < 4; ++m)
#pragma unroll
                    for (int n = 0; n < 2; ++n) acc[a][b][m][n] = (f32x4){0.f, 0.f, 0.f, 0.f};
        cur = nxt; cA = nA; cB = nB; ++ui;
        if (wr == 1) PG8_BAR;
    }
    PG8_WAIT_V(0);
    PG8_BAR;
#undef PG8_SA
#undef PG8_SB
#undef PG8_STAGE
#undef PG8_LDA
#undef PG8_LDB
#undef PG8_MMA
#undef PG8_WAIT_V
#undef PG8_WAIT_L
#undef PG8_BAR
#undef PG8_SCHED
}

struct Sched2 {
    int G, c;
    int n0, nM0, nN0; const char* A0; const char* B0; size_t at0, bt0;
    int n1, nM1, nN1; const char* A1; const char* B1; size_t at1, bt1;
    __device__ __forceinline__ bool next(int i, Unit& u) const {
        long L = (long)i * G + c;
        if (L < n0) { tile_map((int)L, nM0, nN0, u.pm, u.pn); u.kind = 0; u.A = A0 + (size_t)u.pm * at0; u.B = B0 + (size_t)u.pn * bt0; return true; }
        L -= n0;
        if (L < n1) { tile_map((int)L, nM1, nN1, u.pm, u.pn); u.kind = 1; u.A = A1 + (size_t)u.pm * at1; u.B = B1 + (size_t)u.pn * bt1; return true; }
        return false;
    }
};
struct SchedMerge {
    int G, c, nM; const char* BR; const char* WBR;
    __device__ __forceinline__ bool next(int i, Unit& u) const {
        const int rnd = i / 3, br = i - 3 * rnd; const long L = (long)rnd * G + c;
        if (L >= (long)nM * 4) return false;
        tile_map((int)L, nM, 4, u.pm, u.pn); u.kind = br;
        u.A = BR + (size_t)u.pm * 256 * BRW * 2 + (size_t)br * 512 * 2;
        u.B = WBR + (size_t)(br * 4 + u.pn) * 256 * 512 * 2;
        return true;
    }
};

struct SchedSplit {
    int G, c, nks; const char* A; const char* B; size_t lda2, ldb2;
    int kq_per; size_t abr;
    __device__ __forceinline__ bool next(int i, Unit& u) const {
        const long L = (long)i * G + c; if (L >= (long)16 * nks) return false;
        const int t = (int)L / nks, ks = (int)L - t * nks; u.pm = t >> 2; u.pn = t & 3; u.kind = ks;
        const int br = ks / kq_per, kq = ks - br * kq_per;
        u.A = A + (size_t)br * abr + (size_t)u.pm * 256 * lda2 + (size_t)kq * 512; u.B = B + (size_t)u.pn * 256 * ldb2 + (size_t)kq * 512; return true;
    }
};
struct SchedMergeCtx {
    int G, c; const char* BR; const char* WBR;
    __device__ __forceinline__ bool next(int i, Unit& u) const {
        const long L = (long)i * G + c; if (L >= 48) return false;
        const int t = (int)L / 3, br = (int)L - 3 * t; u.pm = 64 + (t >> 2); u.pn = t & 3; u.kind = br;
        u.A = BR + (size_t)u.pm * 256 * BRW * 2 + (size_t)br * 512 * 2;
        u.B = WBR + (size_t)(br * 4 + u.pn) * 256 * 512 * 2;
        return true;
    }
};
struct EpiNull { static constexpr bool PERM = false; float* sink;
    __device__ __forceinline__ void operator()(const f32x4 (&acc)[2][2][4][2], const Unit& u, int wr, int wc, int fr, int fq) const {
        f32x4 t = (f32x4){0.f, 0.f, 0.f, 0.f};
#pragma unroll
        for (int ai = 0; ai < 2; ++ai)
#pragma unroll
            for (int bj = 0; bj < 2; ++bj)
#pragma unroll
                for (int m = 0; m < 4; ++m)
#pragma unroll
                    for (int n = 0; n < 2; ++n) t = t + acc[ai][bj][m][n];
        const float q = (t[0] + t[1]) + (t[2] + t[3]);
        if (q == 1.2345678e33f) *sink = q; } };
struct EpiNullP { static constexpr bool PERM = true; float* sink;
    __device__ __forceinline__ void operator()(const f32x4 (&acc)[2][2][4][2], const Unit& u, int wr, int wc, int fr, int fq) const {
        f32x4 t = (f32x4){0.f, 0.f, 0.f, 0.f};
#pragma unroll
        for (int ai = 0; ai < 2; ++ai)
#pragma unroll
            for (int bj = 0; bj < 2; ++bj)
#pragma unroll
                for (int m = 0; m < 4; ++m)
#pragma unroll
                    for (int n = 0; n < 2; ++n) t = t + acc[ai][bj][m][n];
        const float q = (t[0] + t[1]) + (t[2] + t[3]);
        if (q == 1.2345678e33f) *sink = q; } };
struct EpiPart {
    static constexpr bool PERM = true;
    float* PART;
    __device__ __forceinline__ void operator()(const f32x4 (&acc)[2][2][4][2], const Unit& u, int wr, int wc, int fr_, int fq) const {
        int fr = fr_; asm volatile("" : "+v"(fr));
        float* base = PART + ((size_t)u.kind * MC + (size_t)u.pm * BM) * DM;
        const int row0 = wr * 64 + fr; const int col0 = u.pn * BM + wc * 32 + 8 * fq;
#pragma unroll
        for (int ai = 0; ai < 2; ++ai)
#pragma unroll
            for (int m = 0; m < 4; ++m) { float* rowp = base + (size_t)(row0 + ai * HALF + m * 16) * DM + col0;
#pragma unroll
                for (int bj = 0; bj < 2; ++bj) { *(f32x4*)(rowp + bj * HALF) = acc[ai][bj][m][0]; *(f32x4*)(rowp + bj * HALF + 4) = acc[ai][bj][m][1]; } }
    }
};

__device__ __forceinline__ float silu_f(float a) { return a * __builtin_amdgcn_rcpf(1.f + __expf(-a)); }
__device__ __forceinline__ float sigmoid_f(float a) { return __builtin_amdgcn_rcpf(1.f + __expf(-a)); }

struct EpiUp {
    static constexpr bool PERM = true;
    bf16_t* ACT;
    __device__ __forceinline__ void operator()(const f32x4 (&acc)[2][2][4][2], const Unit& u, int wr, int wc, int fr_, int fq) const {
        int fr = fr_; asm volatile("" : "+v"(fr));
        const int row0 = u.pm * BM + wr * 64 + fr; const int col0 = u.pn * 128 + wc * 32 + 8 * fq;
#pragma unroll
        for (int ai = 0; ai < 2; ++ai)
#pragma unroll
            for (int m = 0; m < 4; ++m) {
                bf16_t* rowp = ACT + (size_t)(row0 + ai * HALF + m * 16) * DFF + col0;
                float v[8];
#pragma unroll
                for (int n = 0; n < 2; ++n)
#pragma unroll
                    for (int j = 0; j < 4; ++j) v[4 * n + j] = silu_f(acc[ai][0][m][n][j]) * acc[ai][1][m][n][j];
                u32x4 w; w.x = pk2(v[0], v[1]); w.y = pk2(v[2], v[3]); w.z = pk2(v[4], v[5]); w.w = pk2(v[6], v[7]);
                *(u32x4*)rowp = w;
            }
    }
};
struct EpiRes {
    static constexpr bool PERM = true;
    bf16_t* HL; bf16_t* HCx; const float* gate;
    float coef; bf16_t* HLw;
    __device__ __forceinline__ void operator()(const f32x4 (&acc)[2][2][4][2], const Unit& u, int wr, int wc, int fr_, int fq) const {
        int fr = fr_; asm volatile("" : "+v"(fr));
        bf16_t* base = u.pm < 64 ? HL + (size_t)u.pm * BM * DM : HCx + (size_t)(u.pm - 64) * BM * DM;
        const int bidx = u.pm < 64 ? (u.pm >> 4) : 4;
        const float* gp = gate + (size_t)bidx * NMODC;
        const int row0 = wr * 64 + fr; const int col0 = u.pn * BM + wc * 32 + 8 * fq;
        bf16_t* wbase = u.pm < 64 ? HLw + (size_t)u.pm * BM * DM : base;
#pragma unroll
        for (int bj = 0; bj < 2; ++bj) {
            const f32x4 g0 = *(const f32x4*)(gp + col0 + bj * HALF) * coef, g1 = *(const f32x4*)(gp + col0 + bj * HALF + 4) * coef;
            u32x4 hv[2][4];
#pragma unroll
            for (int ai = 0; ai < 2; ++ai)
#pragma unroll
                for (int m = 0; m < 4; ++m) hv[ai][m] = *(const u32x4*)(base + (size_t)(row0 + ai * HALF + m * 16) * DM + col0 + bj * HALF);
#pragma unroll
            for (int ai = 0; ai < 2; ++ai)
#pragma unroll
                for (int m = 0; m < 4; ++m) { const f32x4 a0 = acc[ai][bj][m][0], a1 = acc[ai][bj][m][1]; const u32x4 h = hv[ai][m]; u32x4 w;
                    w.x = pk2(bflo(h.x) + g0[0] * a0[0], bfhi(h.x) + g0[1] * a0[1]); w.y = pk2(bflo(h.y) + g0[2] * a0[2], bfhi(h.y) + g0[3] * a0[3]);
                    w.z = pk2(bflo(h.z) + g1[0] * a1[0], bfhi(h.z) + g1[1] * a1[1]); w.w = pk2(bflo(h.w) + g1[2] * a1[2], bfhi(h.w) + g1[3] * a1[3]);
                    *(u32x4*)(wbase + (size_t)(row0 + ai * HALF + m * 16) * DM + col0 + bj * HALF) = w; }
        }
    }
};
template <unsigned GATE_OFF, unsigned GVEC_OFF, unsigned SH_OFF, int INST, bool HW_BR, bool COEF_HALF>
struct EpiResNorm {
    static constexpr bool PERM = true;
    unsigned char* ws; bf16_t* HL; LAS unsigned char* xl;
    __device__ __forceinline__ void operator()(f32x4 (&acc)[2][2][4][2], const Unit& u, int wr, int wc, int fr_, int fq) const {
        int fr = fr_; asm volatile("" : "+v"(fr));
        const int bidx = u.pm >> 4;
        const float* gp = (const float*)(ws + GATE_OFF) + (size_t)bidx * NMODC;
        unsigned* cnt = (unsigned*)(ws + WS_CNT) + INST * 64 * 64;
        const bf16_t* base = HL + (size_t)u.pm * BM * DM;
        const int row0 = wr * 64 + fr; const int col0 = u.pn * BM + wc * 32 + 8 * fq;
        constexpr float cf = COEF_HALF ? 0.5f : 1.0f;
        LAS float* P = (LAS float*)xl;
        {
            const f32x4 g00 = *(const f32x4*)(gp + col0) * cf, g01 = *(const f32x4*)(gp + col0 + 4) * cf, g10 = *(const f32x4*)(gp + col0 + HALF) * cf, g11 = *(const f32x4*)(gp + col0 + HALF + 4) * cf;
#pragma unroll
            for (int ai = 0; ai < 2; ++ai)
#pragma unroll
                for (int m = 0; m < 4; ++m) {
                    const bf16_t* rp = base + (size_t)(row0 + ai * HALF + m * 16) * DM + col0;
                    const u32x4 ha = *(const u32x4*)rp, hb = *(const u32x4*)(rp + HALF);
                    const f32x4 x0 = (f32x4){bflo(ha.x), bfhi(ha.x), bflo(ha.y), bfhi(ha.y)} + g00 * acc[ai][0][m][0];
                    const f32x4 x1 = (f32x4){bflo(ha.z), bfhi(ha.z), bflo(ha.w), bfhi(ha.w)} + g01 * acc[ai][0][m][1];
                    const f32x4 x2 = (f32x4){bflo(hb.x), bfhi(hb.x), bflo(hb.y), bfhi(hb.y)} + g10 * acc[ai][1][m][0];
                    const f32x4 x3 = (f32x4){bflo(hb.z), bfhi(hb.z), bflo(hb.w), bfhi(hb.w)} + g11 * acc[ai][1][m][1];
                    acc[ai][0][m][0] = x0; acc[ai][0][m][1] = x1; acc[ai][1][m][0] = x2; acc[ai][1][m][1] = x3;
                    float sq = ((x0[0] * x0[0] + x0[1] * x0[1]) + (x0[2] * x0[2] + x0[3] * x0[3])) + ((x1[0] * x1[0] + x1[1] * x1[1]) + (x1[2] * x1[2] + x1[3] * x1[3]))
                             + ((x2[0] * x2[0] + x2[1] * x2[1]) + (x2[2] * x2[2] + x2[3] * x2[3])) + ((x3[0] * x3[0] + x3[1] * x3[1]) + (x3[2] * x3[2] + x3[3] * x3[3]));
                    sq += __shfl_xor(sq, 16); sq += __shfl_xor(sq, 32);
                    if (fq == 0) P[(row0 + ai * HALF + m * 16) * 4 + wc] = sq;
                    if (m & 1) asm volatile("" ::: "memory");
                }
        }
        __syncthreads();
        const int trow = wr * 256 + wc * 64 + fq * 16 + fr_;
        float* xs = (float*)(ws + WS_XB) + ((size_t)INST * ML + (size_t)u.pm * BM) * 4;
        if (trow < 256) { const float tot = (P[trow * 4 + 0] + P[trow * 4 + 1]) + (P[trow * 4 + 2] + P[trow * 4 + 3]);
            __hip_atomic_store(xs + trow * 4 + u.pn, tot, __ATOMIC_RELAXED, __HIP_MEMORY_SCOPE_AGENT); }
        __builtin_amdgcn_s_waitcnt(0);
        unsigned* cw = cnt + 64 * u.pm;
        if (fr_ == 0 && fq == 0) (void)__hip_atomic_fetch_add(cw, 1u, __ATOMIC_RELAXED, __HIP_MEMORY_SCOPE_AGENT);
        { unsigned it = 0;
          while (__hip_atomic_load(cw, __ATOMIC_RELAXED, __HIP_MEMORY_SCOPE_AGENT) < 32u) { __builtin_amdgcn_s_sleep(2); if (++it > (1u << 20)) break; } }
        if (trow < 256) { const float t0 = __hip_atomic_load(xs + trow * 4 + 0, __ATOMIC_RELAXED, __HIP_MEMORY_SCOPE_AGENT), t1 = __hip_atomic_load(xs + trow * 4 + 1, __ATOMIC_RELAXED, __HIP_MEMORY_SCOPE_AGENT),
                                      t2 = __hip_atomic_load(xs + trow * 4 + 2, __ATOMIC_RELAXED, __HIP_MEMORY_SCOPE_AGENT), t3 = __hip_atomic_load(xs + trow * 4 + 3, __ATOMIC_RELAXED, __HIP_MEMORY_SCOPE_AGENT);
            P[1024 + trow] = 1.0f / sqrtf(((t0 + t1) + (t2 + t3)) * (1.f / DM) + EPS); }
        __syncthreads();
        bf16_t* hw = (HW_BR ? (bf16_t*)(ws + WS_BR) : HL) + (size_t)u.pm * BM * DM;
        bf16_t* ub = (bf16_t*)(ws + WS_U) + (size_t)u.pm * BM * DM;
        const float* gv = (const float*)(ws + GVEC_OFF); const float* sh = (const float*)(ws + SH_OFF) + (size_t)bidx * NMODC; const float* sc = sh + DM;
        const f32x4 m00 = *(const f32x4*)(gv + col0) * (*(const f32x4*)(sc + col0) + 1.0f), m01 = *(const f32x4*)(gv + col0 + 4) * (*(const f32x4*)(sc + col0 + 4) + 1.0f);
        const f32x4 m10 = *(const f32x4*)(gv + col0 + HALF) * (*(const f32x4*)(sc + col0 + HALF) + 1.0f), m11 = *(const f32x4*)(gv + col0 + HALF + 4) * (*(const f32x4*)(sc + col0 + HALF + 4) + 1.0f);
        const f32x4 s00 = *(const f32x4*)(sh + col0), s01 = *(const f32x4*)(sh + col0 + 4), s10 = *(const f32x4*)(sh + col0 + HALF), s11 = *(const f32x4*)(sh + col0 + HALF + 4);
#pragma unroll
        for (int ai = 0; ai < 2; ++ai)
#pragma unroll
            for (int m = 0; m < 4; ++m) {
                const size_t ro = (size_t)(row0 + ai * HALF + m * 16) * DM + col0;
                const float rstd = P[1024 + row0 + ai * HALF + m * 16];
                const f32x4 x0 = acc[ai][0][m][0], x1 = acc[ai][0][m][1], x2 = acc[ai][1][m][0], x3 = acc[ai][1][m][1];
                u32x4 w; w.x = pk2(x0[0], x0[1]); w.y = pk2(x0[2], x0[3]); w.z = pk2(x1[0], x1[1]); w.w = pk2(x1[2], x1[3]); *(u32x4*)(hw + ro) = w;
                w.x = pk2(x2[0], x2[1]); w.y = pk2(x2[2], x2[3]); w.z = pk2(x3[0], x3[1]); w.w = pk2(x3[2], x3[3]); *(u32x4*)(hw + ro + HALF) = w;
                const f32x4 o0 = (x0 * rstd) * m00 + s00, o1 = (x1 * rstd) * m01 + s01, o2 = (x2 * rstd) * m10 + s10, o3 = (x3 * rstd) * m11 + s11;
                w.x = pk2(o0[0], o0[1]); w.y = pk2(o0[2], o0[3]); w.z = pk2(o1[0], o1[1]); w.w = pk2(o1[2], o1[3]); *(u32x4*)(ub + ro) = w;
                w.x = pk2(o2[0], o2[1]); w.y = pk2(o2[2], o2[3]); w.z = pk2(o3[0], o3[1]); w.w = pk2(o3[2], o3[3]); *(u32x4*)(ub + ro + HALF) = w;
                if (m & 1) asm volatile("" ::: "memory");
            }
    }
};
struct EpiFinal {
    static constexpr bool PERM = true;
    unsigned char* ws; float* out;
    __device__ __forceinline__ void operator()(f32x4 (&acc)[2][2][4][2], const Unit& u, int wr, int wc, int fr_, int fq) const {
        int fr = fr_; asm volatile("" : "+v"(fr));
        const float coef = 0.5f;
        const float* gfin = (const float*)(ws + WS_SM) + SM_GFIN; float* rowsq = (float*)(ws + WS_RSQ); unsigned* cnt = (unsigned*)(ws + WS_CNT);
        const bf16_t* base = (const bf16_t*)(ws + WS_BR) + (size_t)u.pm * BM * DM;
        const float* gp = (const float*)(ws + WS_MOD) + (size_t)5 * NMODC + 8 * DM + (size_t)(u.pm >> 4) * NMODC;
        const int row0 = wr * 64 + fr; const int col0 = u.pn * BM + wc * 32 + 8 * fq;
#pragma unroll
        for (int bj = 0; bj < 2; ++bj) {
            const f32x4 g0 = *(const f32x4*)(gp + col0 + bj * HALF) * coef, g1 = *(const f32x4*)(gp + col0 + bj * HALF + 4) * coef;
            u32x4 hv[2][4];
#pragma unroll
            for (int ai = 0; ai < 2; ++ai)
#pragma unroll
                for (int m = 0; m < 4; ++m) hv[ai][m] = *(const u32x4*)(base + (size_t)(row0 + ai * HALF + m * 16) * DM + col0 + bj * HALF);
#pragma unroll
            for (int ai = 0; ai < 2; ++ai)
#pragma unroll
                for (int m = 0; m < 4; ++m) { const u32x4 h = hv[ai][m]; const f32x4 a0 = acc[ai][bj][m][0], a1 = acc[ai][bj][m][1];
                    acc[ai][bj][m][0] = (f32x4){bflo(h.x), bfhi(h.x), bflo(h.y), bfhi(h.y)} + g0 * a0;
                    acc[ai][bj][m][1] = (f32x4){bflo(h.z), bfhi(h.z), bflo(h.w), bfhi(h.w)} + g1 * a1; }
        }
        float* rq = rowsq + (size_t)u.pm * BM + row0;
#pragma unroll
        for (int ai = 0; ai < 2; ++ai)
#pragma unroll
            for (int m = 0; m < 4; ++m) { float sq = 0.f;
#pragma unroll
                for (int bj = 0; bj < 2; ++bj)
#pragma unroll
                    for (int n = 0; n < 2; ++n) { const f32x4 x = acc[ai][bj][m][n]; sq += (x[0] * x[0] + x[1] * x[1]) + (x[2] * x[2] + x[3] * x[3]); }
                sq += __shfl_xor(sq, 16); sq += __shfl_xor(sq, 32);
                if (fq == 0) (void)__hip_atomic_fetch_add(rq + ai * HALF + m * 16, sq, __ATOMIC_RELAXED, __HIP_MEMORY_SCOPE_AGENT); }
        __builtin_amdgcn_s_waitcnt(0);
        unsigned* cw = cnt + 64 * u.pm;
        if (fr_ == 0 && fq == 0) (void)__hip_atomic_fetch_add(cw, 1u, __ATOMIC_RELAXED, __HIP_MEMORY_SCOPE_AGENT);
        { unsigned it = 0;
          while (__hip_atomic_load(cw, __ATOMIC_RELAXED, __HIP_MEMORY_SCOPE_AGENT) < 32u) { __builtin_amdgcn_s_sleep(2); if (++it > (1u << 20)) break; } }
        float* ob = out + (size_t)u.pm * BM * DM;
#pragma unroll
        for (int ai = 0; ai < 2; ++ai)
#pragma unroll
            for (int m = 0; m < 4; ++m) {
                const float rs = __hip_atomic_load(rq + ai * HALF + m * 16, __ATOMIC_RELAXED, __HIP_MEMORY_SCOPE_AGENT);
                const float rstd = 1.0f / sqrtf(rs * (1.f / DM) + EPS);
#pragma unroll
                for (int bj = 0; bj < 2; ++bj) { const f32x4 f0 = *(const f32x4*)(gfin + col0 + bj * HALF), f1 = *(const f32x4*)(gfin + col0 + bj * HALF + 4);
                    float* op = ob + (size_t)(row0 + ai * HALF + m * 16) * DM + col0 + bj * HALF;
                    *(f32x4*)op = acc[ai][bj][m][0] * rstd * f0; *(f32x4*)(op + 4) = acc[ai][bj][m][1] * rstd * f1; }
            }
    }
};
struct EpiWin {
    static constexpr bool PERM = true;
    bf16_t* P; bf16_t* VT; const float* rope;
    __device__ __forceinline__ void operator()(const f32x4 (&acc)[2][2][4][2], const Unit& u, int wr, int wc, int fr_, int fq) const {
        int fr = fr_; asm volatile("" : "+v"(fr));
        const int row0 = u.pm * BM + wr * 64 + fr;
        if (u.kind == 0) {
            const bool rp = (u.pm < 64) && (u.pn == 4 || u.pn == 5 || (u.pn == 6 && wc < 2));
            const int colb = u.pn * BM + wc * 64 + 8 * fq;
#pragma unroll
            for (int ai = 0; ai < 2; ++ai)
#pragma unroll
                for (int m = 0; m < 4; ++m) {
                    const int row = row0 + ai * HALF + m * 16;
                    float x1[8], x2[8];
#pragma unroll
                    for (int n = 0; n < 2; ++n)
#pragma unroll
                        for (int j = 0; j < 4; ++j) { x1[4 * n + j] = acc[ai][0][m][n][j]; x2[4 * n + j] = acc[ai][1][m][n][j]; }
                    if (rp) {
                        const int t = row & 4095; const int pos = (fq < 2) ? (t >> 6) : (t & 63);
                        const f32x4* rt = (const f32x4*)(rope + ((size_t)pos * 16 + (fq & 1) * 8) * 2);
#pragma unroll
                        for (int q = 0; q < 4; ++q) { const f32x4 cs = rt[q];
                            const float a0 = x1[2 * q], b0 = x2[2 * q], a1 = x1[2 * q + 1], b1 = x2[2 * q + 1];
                            x1[2 * q] = a0 * cs[0] - b0 * cs[1]; x2[2 * q] = a0 * cs[1] + b0 * cs[0];
                            x1[2 * q + 1] = a1 * cs[2] - b1 * cs[3]; x2[2 * q + 1] = a1 * cs[3] + b1 * cs[2]; }
                    }
                    bf16_t* rowp = P + (size_t)row * PW + colb;
                    u32x4 w; w.x = pk2(x1[0], x1[1]); w.y = pk2(x1[2], x1[3]); w.z = pk2(x1[4], x1[5]); w.w = pk2(x1[6], x1[7]);
                    *(u32x4*)rowp = w;
                    w.x = pk2(x2[0], x2[1]); w.y = pk2(x2[2], x2[3]); w.z = pk2(x2[4], x2[5]); w.w = pk2(x2[6], x2[7]);
                    *(u32x4*)(rowp + 32) = w;
                }
        } else {
            const int col0 = u.pn * BM + wc * 32 + 8 * fq;
#pragma unroll
            for (int ai = 0; ai < 2; ++ai)
#pragma unroll
                for (int m = 0; m < 4; ++m) {
                    const int r = row0 + ai * HALF + m * 16;
                    if (u.pm < 3) {
                        bf16_t* vp = VT + (size_t)(r >> 6) * ((size_t)MT * 64) + (size_t)(col0 >> 2) * 256 + (r & 63) * 4;
#pragma unroll
                        for (int bj = 0; bj < 2; ++bj) { const f32x4 v0 = acc[ai][bj][m][0], v1 = acc[ai][bj][m][1];
                            u32x2 w; w.x = pk2(v0[0], v0[1]); w.y = pk2(v0[2], v0[3]); *(u32x2*)(vp + bj * 32 * 256) = w;
                            w.x = pk2(v1[0], v1[1]); w.y = pk2(v1[2], v1[3]); *(u32x2*)(vp + bj * 32 * 256 + 256) = w; }
                    } else {
                    bf16_t* rowp = VT + (size_t)r * MT + col0;
#pragma unroll
                    for (int bj = 0; bj < 2; ++bj) { const f32x4 v0 = acc[ai][bj][m][0], v1 = acc[ai][bj][m][1];
                        u32x4 w; w.x = pk2(v0[0], v0[1]); w.y = pk2(v0[2], v0[3]); w.z = pk2(v1[0], v1[1]); w.w = pk2(v1[2], v1[3]);
                        *(u32x4*)(rowp + bj * HALF) = w; }
                    }
                }
        }
    }
};
struct EpiGate {
    static constexpr bool PERM = true;
    bf16_t* GL;
    __device__ __forceinline__ void operator()(const f32x4 (&acc)[2][2][4][2], const Unit& u, int wr, int wc, int fr_, int fq) const {
        int fr = fr_; asm volatile("" : "+v"(fr));
        const int row0 = u.pm * BM + wr * 64 + fr; const int col0 = u.pn * BM + wc * 32 + 8 * fq;
#pragma unroll
        for (int ai = 0; ai < 2; ++ai)
#pragma unroll
            for (int m = 0; m < 4; ++m) {
                bf16_t* rowp = GL + (size_t)(row0 + ai * HALF + m * 16) * GLW + col0;
#pragma unroll
                for (int bj = 0; bj < 2; ++bj) { const f32x4 v0 = acc[ai][bj][m][0], v1 = acc[ai][bj][m][1];
                    u32x4 w; w.x = pk2(sigmoid_f(v0[0]), sigmoid_f(v0[1])); w.y = pk2(sigmoid_f(v0[2]), sigmoid_f(v0[3]));
                    w.z = pk2(sigmoid_f(v1[0]), sigmoid_f(v1[1])); w.w = pk2(sigmoid_f(v1[2]), sigmoid_f(v1[3]));
                    *(u32x4*)(rowp + bj * HALF) = w; }
            }
    }
};
struct EpiMerge {
    static constexpr bool PERM = true;
    const bf16_t* GL; bf16_t* MG; bf16_t* MGP;
    __device__ __forceinline__ void operator()(const f32x4 (&acc)[2][2][4][2], const Unit& u, int wr, int wc, int fr_, int fq) const {
        int fr = fr_; asm volatile("" : "+v"(fr));
        const int row0 = u.pm * BM + wr * 64 + fr; const int col0 = u.pn * BM + wc * 32 + 8 * fq;
#pragma unroll
        for (int ai = 0; ai < 2; ++ai)
#pragma unroll
            for (int m = 0; m < 4; ++m) {
                const size_t row = (size_t)(row0 + ai * HALF + m * 16);
#pragma unroll
                for (int bj = 0; bj < 2; ++bj) {
                    const u32x4 g = *(const u32x4*)(GL + row * GLW + u.kind * 1024 + col0 + bj * HALF);
                    u32x4* mp = MGP ? (u32x4*)(MGP + ((size_t)u.kind * MC + (row - ML)) * DM + col0 + bj * HALF) : (u32x4*)(MG + row * DM + col0 + bj * HALF);
                    const f32x4 v0 = acc[ai][bj][m][0], v1 = acc[ai][bj][m][1];
                    float r[8];
                    r[0] = bflo(g.x) * v0[0]; r[1] = bfhi(g.x) * v0[1]; r[2] = bflo(g.y) * v0[2]; r[3] = bfhi(g.y) * v0[3];
                    r[4] = bflo(g.z) * v1[0]; r[5] = bfhi(g.z) * v1[1]; r[6] = bflo(g.w) * v1[2]; r[7] = bfhi(g.w) * v1[3];
                    if (u.kind != 0 && !MGP) { const u32x4 o = *mp;
                        r[0] += bflo(o.x); r[1] += bfhi(o.x); r[2] += bflo(o.y); r[3] += bfhi(o.y); r[4] += bflo(o.z); r[5] += bfhi(o.z); r[6] += bflo(o.w); r[7] += bfhi(o.w); }
                    u32x4 w; w.x = pk2(r[0], r[1]); w.y = pk2(r[2], r[3]); w.z = pk2(r[4], r[5]); w.w = pk2(r[6], r[7]);
                    *mp = w;
                }
            }
    }
};
}


#define XB_TMO      128
#define XB_XCNT(j)  (256  + 64 * (j))
#define XB_XSUB(j)  (1280 + 64 * (j))
#define XB_XGEN(j)  (2304 + 64 * (j))
#define XB_TOP      3328
#define XB_TOPGEN   3392
#define XCD_BAR_WORDS 3456
#define XB_SPIN_CAP (1u << 18)
__device__ __forceinline__ unsigned xb_ld(unsigned* p)              { return __hip_atomic_load(p, __ATOMIC_RELAXED, __HIP_MEMORY_SCOPE_AGENT); }
__device__ __forceinline__ unsigned xb_add(unsigned* p, unsigned v) { return __hip_atomic_fetch_add(p, v, __ATOMIC_RELAXED, __HIP_MEMORY_SCOPE_AGENT); }
__device__ __forceinline__ unsigned xb_xcc_id() { return (unsigned)__builtin_amdgcn_s_getreg((3 << 11) | 20) & 0xFu; }
#define XB_SPIN(cond, bar) do { unsigned _sp = 0; while (cond) { __builtin_amdgcn_s_sleep(1); \
    if ((++_sp & 255u) == 0u) { if (xb_ld(&(bar)[XB_TMO])) break; if (_sp > XB_SPIN_CAP) { atomicAdd(&(bar)[XB_TMO], 1u); break; } } } } while (0)
struct XcdBarrier { unsigned* bar; unsigned x; volatile LAS unsigned* st; int wv; };
__device__ __forceinline__ XcdBarrier xcd_barrier_post(unsigned* bar, volatile LAS unsigned* st, int wv) {
    XcdBarrier b; b.bar = bar; b.x = xb_xcc_id(); b.st = st; b.wv = wv;
    if (wv == 0 && lane_now() == 0) (void)xb_add(&bar[XB_XCNT(b.x)], 1u);
    return b;
}
__device__ __forceinline__ void xcd_barrier_complete(unsigned* bar, unsigned x, unsigned& nloc, unsigned& nx) {
    const unsigned G = gridDim.x * gridDim.y * gridDim.z;
    unsigned sum, cnt, mine, sp = 0u;
    for (;;) {
        sum = 0u; cnt = 0u; mine = 0u;
#pragma unroll
        for (unsigned j = 0; j < 16; ++j) { const unsigned c = xb_ld(&bar[XB_XCNT(j)]); sum += c; cnt += (c > 0u) ? 1u : 0u; mine = (j == x) ? c : mine; }
        if (sum == G) break;
        __builtin_amdgcn_s_sleep(1);
        if ((++sp & 255u) == 0u) { if (xb_ld(&bar[XB_TMO])) break; if (sp > XB_SPIN_CAP) { atomicAdd(&bar[XB_TMO], 1u); break; } }
    }
    nloc = mine > 0u ? mine : 1u; nx = cnt > 0u ? cnt : 1u;
}
__device__ __forceinline__ void xcd_barrier(const XcdBarrier& b) {
    asm volatile("s_waitcnt vmcnt(0)" ::: "memory");
    __syncthreads();
    if (b.wv == 0 && lane_now() == 0) {
        unsigned* bar = b.bar;
        __builtin_amdgcn_s_waitcnt(0);
        unsigned nloc = b.st[0], nx = b.st[1];
        if (nloc == 0u) { xcd_barrier_complete(bar, b.x, nloc, nx); b.st[0] = nloc; b.st[1] = nx; }
        const unsigned old = xb_add(&bar[XB_XSUB(b.x)], 1u);
        const unsigned gen = old / nloc;
        if (old + 1u == (gen + 1u) * nloc) {
            __builtin_amdgcn_fence(__ATOMIC_RELEASE, "agent");
            asm volatile("s_waitcnt vmcnt(0)" ::: "memory");
            const unsigned og = xb_add(&bar[XB_TOP], 1u);
            const unsigned tg = og / nx;
            if (og + 1u == (tg + 1u) * nx) xb_add(&bar[XB_TOPGEN], 1u);
            else XB_SPIN(xb_ld(&bar[XB_TOPGEN]) == tg, bar);
            __builtin_amdgcn_fence(__ATOMIC_ACQUIRE, "agent");
            xb_add(&bar[XB_XGEN(b.x)], 1u);
            asm volatile("s_waitcnt vmcnt(0)" ::: "memory");
        } else {
            XB_SPIN(xb_ld(&bar[XB_XGEN(b.x)]) == gen, bar);
            __builtin_amdgcn_fence(__ATOMIC_ACQUIRE, "agent");
            asm volatile("s_waitcnt vmcnt(0)" ::: "memory");
        }
    }
    __syncthreads();
}

struct Args {
    const float* x; const float* c; const float* ctx; const float* c_ctx; const float* w_ada; const float* b_ada; const float* g_ffn1; const float* ffn1_w13; const float* ffn1_w2;
    const float* g_mix; const float* w_in; const float* na_bias; const float* wa_sink; const float* w_br; const float* w_out; const float* g_ffn2; const float* ffn2_w13; const float* ffn2_w2; const float* g_final;
    float* out; unsigned char* ws; int ph_lo, ph_hi;
};

struct Ctx { float* out; unsigned char* ws; const float* x; const float* ctx; int wv; };
__device__ __forceinline__ void transpose_item(const float* W, int K, int Nsrc, int src, bf16_t* WT, int nrow0, int kb, LAS float* scr, int lane) {
    const int k0 = 64 * kb;
    if (src >= 0) {
        float t[32];
#pragma unroll
        for (int i = 0; i < 32; ++i) { const int kk = 2 * i + (lane >> 5); t[i] = W[(size_t)(k0 + kk) * Nsrc + src + (lane & 31)]; }
#pragma unroll
        for (int i = 0; i < 32; ++i) { const int kk = 2 * i + (lane >> 5); scr[kk * 33 + (lane & 31)] = t[i]; }
    } else {
#pragma unroll 8
        for (int i = 0; i < 32; ++i) { const int kk = 2 * i + (lane >> 5); scr[kk * 33 + (lane & 31)] = 0.f; }
    }
    asm volatile("s_waitcnt lgkmcnt(0)" ::: "memory");
    const int c = lane & 7;
#pragma unroll
    for (int j = 0; j < 4; ++j) { const int n = (lane >> 3) + 8 * j; const LAS float* s = scr + (8 * c) * 33 + n;
        u32x4 o; o.x = pk2(s[0 * 33], s[1 * 33]); o.y = pk2(s[2 * 33], s[3 * 33]); o.z = pk2(s[4 * 33], s[5 * 33]); o.w = pk2(s[6 * 33], s[7 * 33]);
        *(u32x4*)(WT + (size_t)(nrow0 + n) * K + k0 + 8 * c) = o; }
    asm volatile("s_waitcnt lgkmcnt(0)" ::: "memory");
}

__device__ __forceinline__ void prep_phase(const Args& a, const int wv_, LAS unsigned char* lds, int G) {
    const int lane = lane_now(), wave = wv_, tid = wave * 64 + lane;
    const int gw = blockIdx.x * 8 + wave, NGW = G * 8;
    LAS float* scr = (LAS float*)(lds + wave * 16384);
    LAS float* tab = (LAS float*)(lds + LDS_X);

    if (tid < 64) { float s, c; sincos_turns((double)tid / 64.0, s, c); tab[tid] = c; tab[64 + tid] = s; }
    __syncthreads();
    constexpr int I13 = 176 * 16, I2 = 32 * 44, IIN = 56 * 16, IINT = 24 * 16, IG = 96 * 16, IBR = 3 * 32 * 8, IOUT = 32 * 16;
    constexpr int IL = 2 * I13 + 2 * I2 + IIN + IINT + IG + IBR + IOUT;
    for (int it = gw; it < 2 * IL; it += NGW) {
        const int l = it / IL; int r = it - l * IL;
        unsigned char* wl = a.ws + WS_W + (size_t)l * WS_WL;
        if (r < 2 * I13) { const int which = r / I13; r -= which * I13; const int gi = r >> 4, kb = r & 15; const int pn = gi >> 3, sub = gi & 7;
            const int src = (sub >> 2) * DFF + 128 * pn + 32 * (sub & 3);
            transpose_item((which ? a.ffn2_w13 : a.ffn1_w13) + (size_t)l * DM * 2 * DFF, DM, 2 * DFF, src, (bf16_t*)(wl + (which ? WO_13B : WO_13A)), 32 * gi, kb, scr, lane); continue; }
        r -= 2 * I13;
        if (r < 2 * I2) { const int which = r / I2; r -= which * I2; const int gi = r / 44, kb = r - gi * 44;
            transpose_item((which ? a.ffn2_w2 : a.ffn1_w2) + (size_t)l * DFF * DM, DFF, DM, 32 * gi, (bf16_t*)(wl + (which ? WO_2B : WO_2A)), 32 * gi, kb, scr, lane); continue; }
        r -= 2 * I2;
        const float* win = a.w_in + (size_t)l * DM * PIN;
        if (r < IIN) { const int gi = r >> 4, kb = r & 15; const int pn = gi >> 3, bj = (gi & 7) >> 2, wc = gi & 3, hp = 4 * pn + wc;
            const int src = (hp < 16 ? 64 * hp : 2048 + 64 * (hp - 16)) + 32 * bj;
            transpose_item(win, DM, PIN, src, (bf16_t*)(wl + WO_IN), 32 * gi, kb, scr, lane); continue; }
        r -= IIN;
        if (r < IINT) { const int gi = r >> 4, kb = r & 15; const int src = gi < 16 ? 1024 + 32 * gi : (gi < 20 ? 2688 + 32 * (gi - 16) : -1);
            transpose_item(win, DM, PIN, src, (bf16_t*)(wl + WO_INT), 32 * gi, kb, scr, lane); continue; }
        r -= IINT;
        if (r < IG) { const int gi = r >> 4, kb = r & 15;
            transpose_item(win, DM, PIN, 2816 + 32 * gi, (bf16_t*)(wl + WO_G), 32 * gi, kb, scr, lane); continue; }
        r -= IG;
        if (r < IBR) { const int br = r / 256; r -= br * 256; const int gi = r >> 3, kb = r & 7;
            transpose_item(a.w_br + ((size_t)l * 3 + br) * 512 * DM, 512, DM, 32 * gi, (bf16_t*)(wl + WO_BR), br * 1024 + 32 * gi, kb, scr, lane); continue; }
        r -= IBR;
        { const int gi = r >> 4, kb = r & 15;
          transpose_item(a.w_out + (size_t)l * DM * DM, DM, DM, 32 * gi, (bf16_t*)(wl + WO_OUT), 32 * gi, kb, scr, lane); }
    }
    for (int it = gw; it < 2 * 8 * 128; it += NGW) {
        const int l = it >> 10, grp = (it >> 7) & 7, k0 = (it & 127) * 8;
        const float* win = a.w_in + (size_t)l * DM * PIN + 1536 + grp * 64;
        bf16_t* wt = (bf16_t*)(a.ws + WS_W + (size_t)l * WS_WL + WO_INT);
        float yr[8], yi[8];
#pragma unroll
        for (int kk = 0; kk < 8; ++kk) { yr[kk] = 0.f; yi[kk] = 0.f; }
        for (int c = 0; c < 64; ++c) {
            const int idx = (c * lane) & 63; const float cs = tab[idx], sn = tab[64 + idx];
#pragma unroll
            for (int kk = 0; kk < 8; ++kk) { const float w = win[(size_t)(k0 + kk) * PIN + c]; yr[kk] += w * cs; yi[kk] -= w * sn; }
        }
        u32x4 o; o.x = pk2(yr[0] * 0.125f, yr[1] * 0.125f); o.y = pk2(yr[2] * 0.125f, yr[3] * 0.125f); o.z = pk2(yr[4] * 0.125f, yr[5] * 0.125f); o.w = pk2(yr[6] * 0.125f, yr[7] * 0.125f);
        *(u32x4*)(wt + (size_t)(768 + grp * 64 + lane) * DM + k0) = o;
        o.x = pk2(yi[0] * 0.125f, yi[1] * 0.125f); o.y = pk2(yi[2] * 0.125f, yi[3] * 0.125f); o.z = pk2(yi[4] * 0.125f, yi[5] * 0.125f); o.w = pk2(yi[6] * 0.125f, yi[7] * 0.125f);
        *(u32x4*)(wt + (size_t)(1280 + grp * 64 + lane) * DM + k0) = o;
    }
    {
        const int gt = blockIdx.x * 512 + tid, NT = G * 512;
        float2* rope = (float2*)(a.ws + WS_ROPE);
        for (int e = gt; e < 64 * 16; e += NT) { const int pos = e >> 4, f = e & 15;
            const float c4 = (f & 3) == 0 ? 1.0f : (f & 3) == 1 ? 0.56234132519034908f : (f & 3) == 2 ? 0.31622776601683794f : 0.17782794100389228f;
            const float p10 = (f >> 2) == 0 ? 1.0f : (f >> 2) == 1 ? 0.1f : (f >> 2) == 2 ? 0.01f : 0.001f;
            const float ang = (float)pos * (c4 * p10);
            const double tt = (double)ang * 0.15915494309189533577; const double fr = tt - __builtin_floor(tt);
            float s, c; sincos_turns(fr, s, c); rope[e] = make_float2(c, s); }
        float2* tw = (float2*)(a.ws + WS_TW);
        for (int e = gt; e < 64 * 64; e += NT) { const int n2 = e >> 6, n1p = e & 63; float s, c; sincos_turns((double)(n2 * n1p) / 4096.0, s, c); tw[e] = make_float2(c * (1.f / 64.f), s * (1.f / 64.f)); }
        bf16_t* fb1 = (bf16_t*)(a.ws + WS_FB1);
        for (int e = gt; e < 4 * 8 * 64 * 8; e += NT) { const int j = e & 7, ln = (e >> 3) & 63, nt = (e >> 9) & 7, ks = e >> 12; const int g = ln >> 4;
            const int k = 32 * ks + 8 * g + j, n = 16 * nt + (ln & 15); const int pk = k >> 6, n1 = k & 63, pn = n >> 6, n1p = n & 63;
            const int q = (n1 * n1p) & 63; const float cs = tab[q], sn = tab[64 + q];
            const float v = (pk == pn) ? cs : (pk == 0 ? -sn : sn);
            fb1[e] = (bf16_t)f2bf(v); }
        bf16_t* a3 = (bf16_t*)(a.ws + WS_A3);
        for (int e = gt; e < 4 * 4 * 64 * 8; e += NT) { const int j = e & 7, ln = (e >> 3) & 63, ks3 = (e >> 9) & 3, m3 = e >> 11; const int g = ln >> 4;
            const int n2p = 16 * m3 + (ln & 15); const int mtA = 2 * (ks3 & 1) + (j >> 2); const int n2 = 16 * mtA + 4 * g + (j & 3);
            const int q = (n2 * n2p) & 63; const float v = (ks3 < 2) ? tab[q] : tab[64 + q];
            a3[e] = (bf16_t)f2bf(v); }
    }
    __syncthreads();
    LAS float* sv = (LAS float*)lds;
    LAS float* red = (LAS float*)(lds + 32768);
    for (int e = tid; e < 5 * DM; e += 512) { const int r = e >> 10, k = e & 1023; const float v = r < 4 ? a.c[r * DM + k] : a.c_ctx[k]; sv[e] = v / (1.f + __expf(-v)); }
    __syncthreads();
    float* mod = (float*)(a.ws + WS_MOD);
    for (int it = blockIdx.x; it < 2 * 144; it += G) {
        const int l = it / 144, n0 = (it - l * 144) * 64;
        const float* w = a.w_ada + (size_t)l * DM * NMODC + n0 + lane;
        float ac[5] = {0.f, 0.f, 0.f, 0.f, 0.f};
        const int kbeg = wave * 128;
#pragma unroll 8
        for (int k = kbeg; k < kbeg + 128; ++k) { const float wv = w[(size_t)k * NMODC];
#pragma unroll
            for (int r = 0; r < 5; ++r) ac[r] += sv[r * DM + k] * wv; }
#pragma unroll
        for (int r = 0; r < 5; ++r) red[(wave * 5 + r) * 64 + lane] = ac[r];
        __syncthreads();
        if (tid < 320) { const int r = tid >> 6; float s = 0.f;
#pragma unroll
            for (int wv = 0; wv < 8; ++wv) s += red[(wv * 5 + r) * 64 + lane];
            mod[((size_t)l * 5 + r) * NMODC + n0 + lane] = s + a.b_ada[(size_t)l * NMODC + n0 + lane]; }
        __syncthreads();
    }
    {
        const int gt = blockIdx.x * 512 + tid, NT = G * 512;
        float* sm = (float*)(a.ws + WS_SM);
        { unsigned* z0 = (unsigned*)(a.ws + WS_RSQ); unsigned* z1 = (unsigned*)(a.ws + WS_CNT); for (int e = gt; e < 6 * ML; e += NT) z0[e] = 0u; for (int e = gt; e < 6 * 64 * 64; e += NT) z1[e] = 0u; }
        for (int e = gt; e < SM_END; e += NT) { float v;
            if (e < SM_GMIX) v = a.g_ffn1[e]; else if (e < SM_GF2) v = a.g_mix[e - SM_GMIX]; else if (e < SM_GFIN) v = a.g_ffn2[e - SM_GF2]; else if (e < SM_SINK) v = a.g_final[e - SM_GFIN];
            else if (e < SM_BIAS) v = (e - SM_SINK) < 16 ? a.wa_sink[e - SM_SINK] : 0.f; else v = a.na_bias[e - SM_BIAS];
            sm[e] = v; }
    }
}

__device__ __forceinline__ bf16_t* h_lat(const Ctx& a) { return (bf16_t*)a.out + (size_t)ML * DM; }
__device__ __forceinline__ f32x4 ld_h4(const bf16_t* p) { const u32x2 w = *(const u32x2*)p; return (f32x4){bflo(w.x), bfhi(w.x), bflo(w.y), bfhi(w.y)}; }
__device__ __forceinline__ void st_h4(bf16_t* p, f32x4 v) { u32x2 w; w.x = pk2(v[0], v[1]); w.y = pk2(v[2], v[3]); *(u32x2*)p = w; }
template <int MODE, int NPARTS = 0, bool LAT = true>
__device__ __forceinline__ void norm_phase(const Ctx& a, int G, int nrows, const float* gvec, const float* modl, int shidx, const float* pgate = nullptr, float pcoef = 0.f, bf16_t* hsrc = nullptr) {
    const int lane = lane_now(), wave = a.wv;
    const int gw = blockIdx.x * 8 + wave, NGW = G * 8;
    bf16_t* HL = hsrc ? hsrc : h_lat(a); bf16_t* HCx = (bf16_t*)(a.ws + WS_HC); bf16_t* U = (bf16_t*)(a.ws + WS_U);
    const float* part = (const float*)(a.ws + WS_BR);
    for (int row0 = gw * 4; LAT && row0 < ML; row0 += NGW * 4) {
        bf16_t* hrow = HL + (size_t)row0 * DM;
        f32x4 v[4][4]; float ss[4];
#pragma unroll
        for (int r = 0; r < 4; ++r) { ss[r] = 0.f;
#pragma unroll
            for (int j = 0; j < 4; ++j) v[r][j] = (MODE == 1) ? *(const f32x4*)(a.x + (size_t)(row0 + r) * DM + 4 * lane + 256 * j) : ld_h4(hrow + (size_t)r * DM + 4 * lane + 256 * j); }
        if (MODE == 1) {
#pragma unroll
            for (int r = 0; r < 4; ++r)
#pragma unroll
                for (int j = 0; j < 4; ++j) { st_h4(hrow + (size_t)r * DM + 4 * lane + 256 * j, v[r][j]); v[r][j] = ld_h4(hrow + (size_t)r * DM + 4 * lane + 256 * j); }
        }
#pragma unroll
        for (int r = 0; r < 4; ++r) {
#pragma unroll
            for (int j = 0; j < 4; ++j) ss[r] += (v[r][j][0] * v[r][j][0] + v[r][j][1] * v[r][j][1]) + (v[r][j][2] * v[r][j][2] + v[r][j][3] * v[r][j][3]);
            ss[r] = 1.0f / sqrtf(wave_sum(ss[r]) * (1.f / DM) + EPS); }
        const int bidx = row0 >> 12;
        const float* sh = modl + (size_t)bidx * NMODC + shidx * DM; const float* sc = sh + DM;
#pragma unroll
        for (int j = 0; j < 4; ++j) { const f32x4 s1 = *(const f32x4*)(sc + 4 * lane + 256 * j), s0 = *(const f32x4*)(sh + 4 * lane + 256 * j), gv = *(const f32x4*)(gvec + 4 * lane + 256 * j);
            const f32x4 mul = gv * (s1 + 1.0f);
#pragma unroll
            for (int r = 0; r < 4; ++r) { const f32x4 o = (v[r][j] * ss[r]) * mul + s0;
                u32x2 w; w.x = pk2(o[0], o[1]); w.y = pk2(o[2], o[3]);
                *(u32x2*)(U + (size_t)(row0 + r) * DM + 4 * lane + 256 * j) = w; } }
    }
    for (int cr = (NGW - 1 - gw); cr < nrows - ML; cr += NGW) {
        bf16_t* hrow = HCx + (size_t)cr * DM;
        f32x4 v[4];
#pragma unroll
        for (int j = 0; j < 4; ++j) v[j] = (MODE == 1) ? *(const f32x4*)(a.ctx + (size_t)cr * DM + 4 * lane + 256 * j) : ld_h4(hrow + 4 * lane + 256 * j);
        if (NPARTS > 0) {
#pragma unroll
            for (int j = 0; j < 4; ++j) { f32x4 pv[NPARTS > 0 ? NPARTS : 1];
#pragma unroll
                for (int ks = 0; ks < NPARTS; ++ks) pv[ks] = *(const f32x4*)(part + ((size_t)ks * MC + cr) * DM + 4 * lane + 256 * j);
                f32x4 sum = pv[0];
#pragma unroll
                for (int ks = 1; ks < NPARTS; ++ks) sum = sum + pv[ks];
                const f32x4 gt = *(const f32x4*)(pgate + 4 * lane + 256 * j) * pcoef;
                v[j] = v[j] + gt * sum; }
        }
        if (MODE == 1 || NPARTS > 0) {
#pragma unroll
            for (int j = 0; j < 4; ++j) { st_h4(hrow + 4 * lane + 256 * j, v[j]); v[j] = ld_h4(hrow + 4 * lane + 256 * j); }
        }
        float ss = 0.f;
#pragma unroll
        for (int j = 0; j < 4; ++j) ss += (v[j][0] * v[j][0] + v[j][1] * v[j][1]) + (v[j][2] * v[j][2] + v[j][3] * v[j][3]);
        ss = 1.0f / sqrtf(wave_sum(ss) * (1.f / DM) + EPS);
        const float* sh = modl + (size_t)4 * NMODC + shidx * DM; const float* sc = sh + DM;
#pragma unroll
        for (int j = 0; j < 4; ++j) { const f32x4 s1 = *(const f32x4*)(sc + 4 * lane + 256 * j), s0 = *(const f32x4*)(sh + 4 * lane + 256 * j), gv = *(const f32x4*)(gvec + 4 * lane + 256 * j);
            const f32x4 o = (v[j] * ss) * (gv * (s1 + 1.0f)) + s0;
            u32x2 w; w.x = pk2(o[0], o[1]); w.y = pk2(o[2], o[3]);
            *(u32x2*)(U + (size_t)(ML + cr) * DM + 4 * lane + 256 * j) = w; }
    }
}
__device__ __forceinline__ void final_phase(const Ctx& a, int G, const float* gvec) {
    const int lane = lane_now(), wave = a.wv;
    const int gw = blockIdx.x * 8 + wave, NGW = G * 8;
    const bf16_t* HF = (const bf16_t*)(a.ws + WS_BR);
    for (int row0 = gw * 4; row0 < ML; row0 += NGW * 4) {
        f32x4 v[4][4]; float ss[4];
#pragma unroll
        for (int r = 0; r < 4; ++r) { ss[r] = 0.f;
#pragma unroll
            for (int j = 0; j < 4; ++j) { v[r][j] = ld_h4(HF + (size_t)(row0 + r) * DM + 4 * lane + 256 * j); ss[r] += (v[r][j][0] * v[r][j][0] + v[r][j][1] * v[r][j][1]) + (v[r][j][2] * v[r][j][2] + v[r][j][3] * v[r][j][3]); } }
#pragma unroll
        for (int r = 0; r < 4; ++r) ss[r] = 1.0f / sqrtf(wave_sum(ss[r]) * (1.f / DM) + EPS);
#pragma unroll
        for (int j = 0; j < 4; ++j) { const f32x4 gv = *(const f32x4*)(gvec + 4 * lane + 256 * j);
#pragma unroll
            for (int r = 0; r < 4; ++r) *(f32x4*)(a.out + (size_t)(row0 + r) * DM + 4 * lane + 256 * j) = v[r][j] * ss[r] * gv; }
    }
}

struct KV { bf16x8 ka0, ka1, kb0, kb1; u32x4 v[4]; };
struct Tile { float m, l; f32x4 o[4]; };
__device__ __forceinline__ void kv_load(KV& kv, const bf16_t* Kb, const bf16_t* Vb, int kt0, int kt1) {
    const bf16_t* K0 = Kb + (size_t)kt0 * PW; const bf16_t* K1 = Kb + (size_t)kt1 * PW;
    kv.ka0 = *(const bf16x8*)K0; kv.ka1 = *(const bf16x8*)(K0 + 32); kv.kb0 = *(const bf16x8*)K1; kv.kb1 = *(const bf16x8*)(K1 + 32);
#pragma unroll
    for (int db = 0; db < 4; ++db) { const u32x2 lo = *(const u32x2*)(Vb + (size_t)kt0 * 64 + db * 64), hi = *(const u32x2*)(Vb + (size_t)kt1 * 64 + db * 64); kv.v[db] = (u32x4){lo.x, lo.y, hi.x, hi.y}; }
}
__device__ __forceinline__ void tile_compute(Tile& st, const LAS bf16x8* qlds, const KV& kv, f32x4 b0, f32x4 b1, const int bp16, const int bp32) {
    const bf16x8 q0 = qlds[0], q1 = qlds[64];
    f32x4 s0 = __builtin_amdgcn_mfma_f32_16x16x32_bf16(kv.ka0, q0, b0, 0, 0, 0);
    s0 = __builtin_amdgcn_mfma_f32_16x16x32_bf16(kv.ka1, q1, s0, 0, 0, 0);
    f32x4 s1 = __builtin_amdgcn_mfma_f32_16x16x32_bf16(kv.kb0, q0, b1, 0, 0, 0);
    s1 = __builtin_amdgcn_mfma_f32_16x16x32_bf16(kv.kb1, q1, s1, 0, 0, 0);
    float mx = fmaxf(fmaxf(fmaxf(s0[0], s0[1]), fmaxf(s0[2], s0[3])), fmaxf(fmaxf(s1[0], s1[1]), fmaxf(s1[2], s1[3])));
    mx = fmaxf(mx, __builtin_bit_cast(float, __builtin_amdgcn_ds_bpermute(bp16, __builtin_bit_cast(int, mx))));
    mx = fmaxf(mx, __builtin_bit_cast(float, __builtin_amdgcn_ds_bpermute(bp32, __builtin_bit_cast(int, mx))));
    if (__builtin_amdgcn_ballot_w64(mx > st.m) != 0ull) {
        const float mn = fmaxf(st.m, mx); const float alpha = __builtin_amdgcn_exp2f(st.m - mn); st.l *= alpha; st.m = mn;
#pragma unroll
        for (int db = 0; db < 4; ++db) st.o[db] = st.o[db] * alpha; }
    const float mn = st.m;
    float p[8];
#pragma unroll
    for (int i = 0; i < 4; ++i) { p[i] = __builtin_amdgcn_exp2f(s0[i] - mn); p[4 + i] = __builtin_amdgcn_exp2f(s1[i] - mn); }
    st.l += ((p[0] + p[1]) + (p[2] + p[3])) + ((p[4] + p[5]) + (p[6] + p[7]));
    u32x4 pw; pw.x = pk2(p[0], p[1]); pw.y = pk2(p[2], p[3]); pw.z = pk2(p[4], p[5]); pw.w = pk2(p[6], p[7]);
    const bf16x8 pb = __builtin_bit_cast(bf16x8, pw);
#pragma unroll
    for (int db = 0; db < 4; ++db) st.o[db] = __builtin_amdgcn_mfma_f32_16x16x32_bf16(__builtin_bit_cast(bf16x8, kv.v[db]), pb, st.o[db], 0, 0, 0);
    __builtin_amdgcn_sched_barrier(0);
}

__device__ __forceinline__ void pair_compute(Tile (&T)[4], const LAS bf16x8* qlds, const KV& cur, const LAS float* btab, const int p, const int kind, const int h, const int r0, const int krlo,
                                             const int bs, const int qc, const int wsx, const int qt, const int qpos, const int g, const int bp16, const int bp32) {
    const f32x4 zero4 = (f32x4){0.f, 0.f, 0.f, 0.f};
    f32x4 bc0 = zero4, bc1 = zero4; bool anyv = true;
    int dca[4], dcb[4]; bool vla[4], vlb[4];
    const int kr = krlo + p - 8;
    const bool loc = p >= 8;
    if (loc) {
        if (kind == 0) {
#pragma unroll
            for (int i = 0; i < 4; ++i) { const int kca = bs + 4 * g + i, kcb = kca + 16;
                dca[i] = min(max(kca - qc, -15), 15) + 15; dcb[i] = min(max(kcb - qc, -15), 15) + 15;
                vla[i] = (kca >= wsx && kca < wsx + 16); vlb[i] = (kcb >= wsx && kcb < wsx + 16); }
        } else {
            const int kp0 = qt * 16 - 128 + 32 * (p - 8), kp1 = kp0 + 16;
            const bool v0 = kp0 >= 0 && kp0 < SEQ, v1 = (p - 8 < 8) && kp1 >= 0 && kp1 < SEQ;
#pragma unroll
            for (int i = 0; i < 4; ++i) { const int da = kp0 + 4 * g + i - qpos, db2 = kp1 + 4 * g + i - qpos;
                bc0[i] = (v0 && da >= -128 && da <= 128) ? 0.f : -1e30f; bc1[i] = (v1 && db2 >= -128 && db2 <= 128) ? 0.f : -1e30f; }
            anyv = v0 || v1;
        }
    }
    const bool na_loc = (kind == 0) && loc;
#pragma unroll
    for (int j = 0; j < 4; ++j) {
        bool act = anyv; f32x4 b0 = bc0, b1 = bc1;
        if (na_loc) { const int rj = r0 + j; const int rsj = min(max(rj - 4, 0), 56); act = (kr >= rsj && kr <= rsj + 7);
            if (act) { const LAS float* brow = btab + h * 465 + (kr - rj + 7) * 31;
#pragma unroll
                for (int i = 0; i < 4; ++i) { b0[i] = vla[i] ? brow[dca[i]] : -1e30f; b1[i] = vlb[i] ? brow[dcb[i]] : -1e30f; } } }
        if (act) tile_compute(T[j], qlds + j * 128, cur, b0, b1, bp16, bp32);
    }
}

__device__ __forceinline__ void attn_multi(const Ctx& a, LAS unsigned char* lds, const LAS float* btab, int layer, int kind, int id) {
    const int lane = lane_now(), fr = lane & 15, g = lane >> 4;
    const bf16_t* P = (const bf16_t*)(a.ws + WS_R1); const bf16_t* VT = (const bf16_t*)(a.ws + WS_VT); bf16_t* BR = (bf16_t*)(a.ws + WS_BR);
    const float* sinks = (const float*)(a.ws + WS_SM) + SM_SINK + layer * 8;
    int b, h = 0, q0b, q0s, qcb, qcs, kcol, vrow; bool has_sink = false;
    int r0 = 0, cb = 0, qt = 0, kvh = 0, np = 8;
    if (kind == 0) { cb = id & 3; r0 = ((id >> 2) & 15) * 4; h = (id >> 6) & 7; b = id >> 9; q0b = b * SEQ + r0 * 64 + cb * 16; q0s = 64; qcb = h * 64; qcs = 0; kcol = 512 + h * 64; vrow = h * 64; }
    else if (kind == 1) { qt = id & 255; kvh = (id >> 8) & 1; b = id >> 9; q0b = b * SEQ + qt * 16; q0s = 0; qcb = 1024 + kvh * 256; qcs = 64; kcol = 1536 + kvh * 64; vrow = 512 + kvh * 64; has_sink = true; np = 17; }
    else if (kind == 2) { const int qq = id & 3; h = (id >> 2) & 7; b = id >> 5; q0b = ML + b * CTXL + qq * 64; q0s = 16; qcb = h * 64; qcs = 0; kcol = 512 + h * 64; vrow = h * 64; }
    else { qt = id & 15; kvh = (id >> 4) & 1; b = id >> 5; q0b = ML + b * CTXL + qt * 16; q0s = 0; qcb = 1024 + kvh * 256; qcs = 64; kcol = 1536 + kvh * 64; vrow = 512 + kvh * 64; has_sink = true; }
    Tile T[4];
    LAS bf16x8* qlds = (LAS bf16x8*)(lds + a.wv * 8192) + lane;
#pragma unroll
    for (int j = 0; j < 4; ++j) { const bf16_t* qp = P + (size_t)(q0b + j * q0s + fr) * PW + qcb + j * qcs + 8 * g; { const u32x4 qa = *(const u32x4*)qp, qb = *(const u32x4*)(qp + 32); u32x4 sa, sb;
          sa.x = pk2(bflo(qa.x) * 0.18033688011112042f, bfhi(qa.x) * 0.18033688011112042f); sa.y = pk2(bflo(qa.y) * 0.18033688011112042f, bfhi(qa.y) * 0.18033688011112042f); sa.z = pk2(bflo(qa.z) * 0.18033688011112042f, bfhi(qa.z) * 0.18033688011112042f); sa.w = pk2(bflo(qa.w) * 0.18033688011112042f, bfhi(qa.w) * 0.18033688011112042f);
          sb.x = pk2(bflo(qb.x) * 0.18033688011112042f, bfhi(qb.x) * 0.18033688011112042f); sb.y = pk2(bflo(qb.y) * 0.18033688011112042f, bfhi(qb.y) * 0.18033688011112042f); sb.z = pk2(bflo(qb.z) * 0.18033688011112042f, bfhi(qb.z) * 0.18033688011112042f); sb.w = pk2(bflo(qb.w) * 0.18033688011112042f, bfhi(qb.w) * 0.18033688011112042f);
          qlds[j * 128] = __builtin_bit_cast(bf16x8, sa); qlds[j * 128 + 64] = __builtin_bit_cast(bf16x8, sb); }
        T[j].m = -1e30f; T[j].l = 0.f;
#pragma unroll
        for (int db = 0; db < 4; ++db) T[j].o[db] = (f32x4){0.f, 0.f, 0.f, 0.f}; }
    const bf16_t* Kb = P + (size_t)fr * PW + kcol + 8 * g;
    const bf16_t* Vb = VT + (size_t)(vrow >> 6) * ((size_t)MT * 64) + fr * 4 + g * 256;
    const int kc0 = ML + b * CTXL;
    const int krlo = min(max(r0 - 4, 0), 56), krhi = min(max(r0 + 3 - 4, 0), 56) + 7;
    const int bs = min(max(cb * 16 - 8, 0), 32); const int qc = cb * 16 + fr; const int wsx = min(max(qc - 8, 0), 48);
    if (kind == 0) np = 8 + (krhi - krlo + 1);
    const int qpos = qt * 16 + fr;
    const f32x4 zero4 = (f32x4){0.f, 0.f, 0.f, 0.f};
#define PAIR_KT(pp, kt0, kt1) do { if ((pp) < 8) { kt0 = kc0 + 32 * (pp); kt1 = kt0 + 16; } \
        else if (kind == 0) { kt0 = b * SEQ + (krlo + (pp) - 8) * 64 + bs; kt1 = kt0 + 16; } \
        else { const int kp0_ = qt * 16 - 128 + 32 * ((pp) - 8); kt0 = b * SEQ + min(max(kp0_, 0), SEQ - 16); kt1 = b * SEQ + min(max(kp0_ + 16, 0), SEQ - 16); } } while (0)
    const int bp16 = (lane ^ 16) * 4, bp32 = (lane ^ 32) * 4;
    KV ka, kb;
    kv_load(ka, Kb, Vb, kc0, kc0 + 16);
#pragma unroll 1
    for (int p = 0; p < np; p += 2) {
        if (p + 1 < np) { int kt0, kt1; PAIR_KT(p + 1, kt0, kt1); kv_load(kb, Kb, Vb, kt0, kt1); }
        pair_compute(T, qlds, ka, btab, p, kind, h, r0, krlo, bs, qc, wsx, qt, qpos, g, bp16, bp32);
        if (p + 1 < np) {
            if (p + 2 < np) { int kt0, kt1; PAIR_KT(p + 2, kt0, kt1); kv_load(ka, Kb, Vb, kt0, kt1); }
            pair_compute(T, qlds, kb, btab, p + 1, kind, h, r0, krlo, bs, qc, wsx, qt, qpos, g, bp16, bp32);
        }
    }
#undef PAIR_KT
#pragma unroll
    for (int j = 0; j < 4; ++j) {
        float lt = T[j].l; lt += __shfl_xor(lt, 16); lt += __shfl_xor(lt, 32);
        if (has_sink) lt += __builtin_amdgcn_exp2f(sinks[4 * kvh + j] * 1.4426950408889634f - T[j].m);
        const float inv = 1.0f / lt;
        bf16_t* op = BR + (size_t)(q0b + j * q0s + fr) * BRW + qcb + j * qcs + 4 * g;
#pragma unroll
        for (int db = 0; db < 4; ++db) { const f32x4 o = T[j].o[db] * inv; u32x2 w; w.x = pk2(o[0], o[1]); w.y = pk2(o[2], o[3]); *(u32x2*)(op + db * 16) = w; }
    }
}

__device__ __forceinline__ void fourier_unit(const Ctx& a, LAS unsigned char* lds, int unit) {
    const int lane = lane_now(), wave = a.wv, tid = wave * 64 + lane, fr = lane & 15, g = lane >> 4;
    const int b = unit >> 6, cg8 = unit & 63; const int cY = cg8 * 8 + wave;
    const bf16_t* YT = (const bf16_t*)(a.ws + WS_VT); bf16_t* BR = (bf16_t*)(a.ws + WS_BR);
    const bf16x8* FB1 = (const bf16x8*)(a.ws + WS_FB1); const bf16x8* A3 = (const bf16x8*)(a.ws + WS_A3); const float2* TW = (const float2*)(a.ws + WS_TW);
    LAS bf16_t* inp = (LAS bf16_t*)(lds + wave * 16384);
    LAS bf16_t* stg = (LAS bf16_t*)(lds + LDS_X + 15360);
    {
        const u32x4* s0 = (const u32x4*)(YT + (size_t)(768 + cY) * MT + (size_t)b * SEQ) + lane;
        const u32x4* s1 = (const u32x4*)(YT + (size_t)(1280 + cY) * MT + (size_t)b * SEQ) + lane;
        u32x4 v[8];
#pragma unroll
        for (int i = 0; i < 8; ++i) v[i] = s0[i * 64];
#pragma unroll
        for (int i = 0; i < 8; ++i) *(LAS u32x4*)(inp + (i * 64 + lane) * 8) = v[i];
#pragma unroll
        for (int i = 0; i < 8; ++i) v[i] = s1[i * 64];
#pragma unroll
        for (int i = 0; i < 8; ++i) *(LAS u32x4*)(inp + 4096 + (i * 64 + lane) * 8) = v[i];
    }
#pragma unroll 1
    for (int nt3 = 0; nt3 < 4; ++nt3) {
        bf16x8 fb[4][2];
#pragma unroll
        for (int ks = 0; ks < 4; ++ks) { fb[ks][0] = FB1[(ks * 8 + nt3) * 64 + lane]; fb[ks][1] = FB1[(ks * 8 + nt3 + 4) * 64 + lane]; }
        const bf16x8* A3p = A3; asm volatile("" : "+v"(A3p));
        bf16x8 a3[4][4];
#pragma unroll
        for (int m3 = 0; m3 < 4; ++m3)
#pragma unroll
            for (int ks3 = 0; ks3 < 4; ++ks3) a3[m3][ks3] = A3p[(m3 * 4 + ks3) * 64 + lane];
        f32x4 zr[4], zi[4];
#pragma unroll
        for (int mt = 0; mt < 4; ++mt) {
            zr[mt] = (f32x4){0.f, 0.f, 0.f, 0.f}; zi[mt] = (f32x4){0.f, 0.f, 0.f, 0.f};
#pragma unroll
            for (int ks = 0; ks < 4; ++ks) {
                const LAS bf16_t* src = inp + (ks >> 1) * 4096 + (32 * (ks & 1) + 8 * g) * 64 + 16 * mt + fr;
                bf16x8 A1;
#pragma unroll
                for (int j = 0; j < 8; ++j) A1[j] = (short)src[j * 64];
                zr[mt] = __builtin_amdgcn_mfma_f32_16x16x32_bf16(A1, fb[ks][0], zr[mt], 0, 0, 0);
                zi[mt] = __builtin_amdgcn_mfma_f32_16x16x32_bf16(A1, fb[ks][1], zi[mt], 0, 0, 0);
            }
        }
#pragma unroll
        for (int mt = 0; mt < 4; ++mt)
#pragma unroll
            for (int i = 0; i < 4; ++i) { const float2 cs = TW[(16 * mt + 4 * g + i) * 64 + 16 * nt3 + fr];
                const float r_ = zr[mt][i], i_ = zi[mt][i]; zr[mt][i] = r_ * cs.x + i_ * cs.y; zi[mt][i] = i_ * cs.x - r_ * cs.y; }
        bf16x8 B3[4];
        { u32x4 w;
          w.x = pk2(zr[0][0], zr[0][1]); w.y = pk2(zr[0][2], zr[0][3]); w.z = pk2(zr[1][0], zr[1][1]); w.w = pk2(zr[1][2], zr[1][3]); B3[0] = __builtin_bit_cast(bf16x8, w);
          w.x = pk2(zr[2][0], zr[2][1]); w.y = pk2(zr[2][2], zr[2][3]); w.z = pk2(zr[3][0], zr[3][1]); w.w = pk2(zr[3][2], zr[3][3]); B3[1] = __builtin_bit_cast(bf16x8, w);
          w.x = pk2(zi[0][0], zi[0][1]); w.y = pk2(zi[0][2], zi[0][3]); w.z = pk2(zi[1][0], zi[1][1]); w.w = pk2(zi[1][2], zi[1][3]); B3[2] = __builtin_bit_cast(bf16x8, w);
          w.x = pk2(zi[2][0], zi[2][1]); w.y = pk2(zi[2][2], zi[2][3]); w.z = pk2(zi[3][0], zi[3][1]); w.w = pk2(zi[3][2], zi[3][3]); B3[3] = __builtin_bit_cast(bf16x8, w); }
#pragma unroll
        for (int m3 = 0; m3 < 4; ++m3) {
            f32x4 o = (f32x4){0.f, 0.f, 0.f, 0.f};
#pragma unroll
            for (int ks3 = 0; ks3 < 4; ++ks3) o = __builtin_amdgcn_mfma_f32_16x16x32_bf16(a3[m3][ks3], B3[ks3], o, 0, 0, 0);
#pragma unroll
            for (int i = 0; i < 4; ++i) { const int n2p = 16 * m3 + 4 * g + i; stg[(n2p * 16 + fr) * 8 + wave] = (bf16_t)f2bf(o[i]); }
        }
        __syncthreads();
        for (int e = tid; e < 1024; e += 512) { const int n2p = e >> 4, f = e & 15; const int tok = 16 * nt3 + f + 64 * n2p;
            const u32x4 v = *(const LAS u32x4*)(stg + e * 8); *(u32x4*)(BR + (size_t)(b * SEQ + tok) * BRW + 512 + cg8 * 8) = v; }
        __syncthreads();
    }
}

__device__ __forceinline__ void mix_phase(const Ctx& a, LAS unsigned char* lds, int G, int layer) {
    const int lane = lane_now(), wave = a.wv, tid = wave * 64 + lane;
    const int gw = blockIdx.x * 8 + wave, NGW = G * 8;
    LAS float* btab = (LAS float*)(lds + LDS_X);
    { const float* src = (const float*)(a.ws + WS_SM) + SM_BIAS + layer * 3720; for (int e = tid; e < 3720; e += 512) btab[e] = src[e] * 1.4426950408889634f; }
    for (int u = blockIdx.x; u < 256; u += G) fourier_unit(a, lds, u);
    LAS float* t256 = (LAS float*)(lds + 65536);
    if (layer == 0) { if (tid < 256) { float s, c; sincos_turns((double)tid / 256.0, s, c); t256[tid] = c; t256[256 + tid] = s; } }
    __syncthreads();
    const int n_c = (layer == 0) ? 128 : 0;
    const int total = 4096 + 2 * n_c;
    for (int id = gw; id < total; id += NGW) {
        int kind, uid;
        if (id < 2048) { kind = 0; uid = id; } else if (id < 4096) { kind = 1; uid = id - 2048; } else if (id < 4096 + n_c) { kind = 2; uid = id - 4096; } else { kind = 3; uid = id - 4096 - n_c; }
        attn_multi(a, lds, btab, layer, kind, uid);
    }
    if (layer == 0) {
        const bf16_t* YT = (const bf16_t*)(a.ws + WS_VT); bf16_t* BR = (bf16_t*)(a.ws + WS_BR);
        for (int it = gw; it < 4 * 512 * 4; it += NGW) {
            const int q = it & 3, cp = (it >> 2) & 511, b = it >> 11; const int np = 64 * q + lane;
            const u32x4* yr = (const u32x4*)(YT + (size_t)(768 + cp) * MT + ML + b * CTXL); const u32x4* yi = (const u32x4*)(YT + (size_t)(1280 + cp) * MT + ML + b * CTXL);
            float acc = 0.f;
#pragma unroll 2
            for (int n8 = 0; n8 < 32; ++n8) { const u32x4 r = yr[n8], im = yi[n8];
                const unsigned rw[4] = {r.x, r.y, r.z, r.w}, iw[4] = {im.x, im.y, im.z, im.w};
#pragma unroll
                for (int e = 0; e < 4; ++e) { const int n = 8 * n8 + 2 * e; const int i0 = (n * np) & 255, i1 = ((n + 1) * np) & 255;
                    acc += t256[i0] * bflo(rw[e]) + t256[256 + i0] * bflo(iw[e]); acc += t256[i1] * bfhi(rw[e]) + t256[256 + i1] * bfhi(iw[e]); } }
            BR[(size_t)(ML + b * CTXL + np) * BRW + 512 + cp] = (bf16_t)f2bf(acc * (1.f / 16.f));
        }
    }
}

constexpr int N_PHASES = 25;
template <int L>
__device__ __forceinline__ void layer_phases(const Ctx& cx, const XcdBarrier& xb, LAS unsigned char* lds, const int G, const int c, const int lo, const int hi) {
    unsigned char* ws = cx.ws;
    bf16_t* HL = h_lat(cx); bf16_t* HCx = (bf16_t*)(ws + WS_HC);
    const float* mod = (const float*)(ws + WS_MOD);
    const float* sm = (const float*)(ws + WS_SM);
    constexpr bool last = (L == 1);
    const unsigned char* wl = ws + WS_W + (size_t)L * WS_WL;
    const float* modl = mod + (size_t)L * 5 * NMODC;
    constexpr int Mfull = MT, Mlat = last ? ML : MT;
    constexpr int P0 = 1 + 12 * L;
#define IN(k) (lo <= (k) && (k) < hi)
#define SEAM(k) do { if (IN(k) && IN((k) + 1)) xcd_barrier(xb); } while (0)
    if (IN(P0 + 0)) { if (L == 0) norm_phase<1>(cx, G, MT, sm + SM_GF1 + L * DM, modl, 0); else norm_phase<0, 11, false>(cx, G, MT, sm + SM_GF1 + L * DM, modl, 0, mod + 4 * NMODC + 8 * DM, 0.5f); }
    SEAM(P0 + 0);
    if (IN(P0 + 1)) {
        pg8::Sched2 S{}; S.G = G; S.c = c; S.nM0 = Mfull / 256; S.nN0 = 22; S.n0 = S.nM0 * S.nN0; S.A0 = (const char*)(ws + WS_U); S.B0 = (const char*)(wl + WO_13A);
        S.at0 = (size_t)256 * DM * 2; S.bt0 = (size_t)256 * DM * 2; S.n1 = 0;
        pg8::EpiUp E{(bf16_t*)(ws + WS_R1)};
        if ((NULLMASK >> (P0 + 1)) & 1u) { pg8::EpiNullP E0{(float*)(ws + 32768)}; pg8::gemm_phase(cx.wv, lds, DM, DM, DM, S, E0); }
        pg8::gemm_phase(cx.wv, lds, DM, DM, DM, S, E); if ((REPMASK >> (P0 + 1)) & 1u) { xcd_barrier(xb); pg8::gemm_phase(cx.wv, lds, DM, DM, DM, S, E); } }
    SEAM(P0 + 1);
    if (IN(P0 + 2)) {
        { pg8::Sched2 S{}; S.G = G; S.c = c; S.nM0 = ML / 256; S.nN0 = 4; S.n0 = S.nM0 * S.nN0; S.A0 = (const char*)(ws + WS_R1); S.B0 = (const char*)(wl + WO_2A);
          S.at0 = (size_t)256 * DFF * 2; S.bt0 = (size_t)256 * DFF * 2; S.n1 = 0;
          pg8::EpiResNorm<(unsigned)(WS_MOD + ((size_t)L * 5 * NMODC + 2 * DM) * 4), (unsigned)(WS_SM + (size_t)(SM_GMIX + L * DM) * 4), (unsigned)(WS_MOD + ((size_t)L * 5 * NMODC + 3 * DM) * 4), (L == 0 ? 1 : 4), false, true> E{ws, HL, lds + LDS_X};
          pg8::gemm_phase(cx.wv, lds, DFF, DFF, DFF, S, E); }
        { pg8::SchedSplit S{G, c, 11, (const char*)(ws + WS_R1) + (size_t)ML * DFF * 2, (const char*)(wl + WO_2A), (size_t)DFF * 2, (size_t)DFF * 2, 11, 0};
          pg8::EpiPart E{(float*)(ws + WS_BR)};
          pg8::gemm_phase(cx.wv, lds, 256, DFF, DFF, S, E); } }
    SEAM(P0 + 2);
    if (IN(P0 + 3)) norm_phase<0, 11, false>(cx, G, MT, sm + SM_GMIX + L * DM, modl, 3, modl + 4 * NMODC + 2 * DM, 0.5f);
    SEAM(P0 + 3);
    if (IN(P0 + 4)) {
        pg8::Sched2 S{}; S.G = G; S.c = c;
        S.nM0 = MT / 256; S.nN0 = 7; S.n0 = S.nM0 * S.nN0; S.A0 = (const char*)(ws + WS_U); S.B0 = (const char*)(wl + WO_IN); S.at0 = (size_t)256 * DM * 2; S.bt0 = (size_t)256 * DM * 2;
        S.nM1 = 7; S.nN1 = MT / 256; S.n1 = S.nM1 * S.nN1; S.A1 = (const char*)(wl + WO_INT); S.B1 = (const char*)(ws + WS_U); S.at1 = (size_t)256 * DM * 2; S.bt1 = (size_t)256 * DM * 2;
        pg8::EpiWin E{(bf16_t*)(ws + WS_R1), (bf16_t*)(ws + WS_VT), (const float*)(ws + WS_ROPE)};
        pg8::gemm_phase(cx.wv, lds, DM, DM, DM, S, E); if ((REPMASK >> (P0 + 4)) & 1u) { xcd_barrier(xb); pg8::gemm_phase(cx.wv, lds, DM, DM, DM, S, E); } }
    SEAM(P0 + 4);
    if (IN(P0 + 5)) { mix_phase(cx, lds, G, L); if ((REPMASK >> (P0 + 5)) & 1u) { xcd_barrier(xb); mix_phase(cx, lds, G, L); } }
    SEAM(P0 + 5);
    if (IN(P0 + 6)) {
        pg8::Sched2 S{}; S.G = G; S.c = c; S.nM0 = Mlat / 256; S.nN0 = 12; S.n0 = S.nM0 * S.nN0; S.A0 = (const char*)(ws + WS_U); S.B0 = (const char*)(wl + WO_G);
        S.at0 = (size_t)256 * DM * 2; S.bt0 = (size_t)256 * DM * 2; S.n1 = 0;
        pg8::EpiGate E{(bf16_t*)(ws + WS_R1)};
        pg8::gemm_phase(cx.wv, lds, DM, DM, DM, S, E); if ((REPMASK >> (P0 + 6)) & 1u) { xcd_barrier(xb); pg8::gemm_phase(cx.wv, lds, DM, DM, DM, S, E); } }
    SEAM(P0 + 6);
    if (IN(P0 + 7)) {
        { pg8::SchedMerge S{G, c, ML / 256, (const char*)(ws + WS_BR), (const char*)(wl + WO_BR)};
          pg8::EpiMerge E{(const bf16_t*)(ws + WS_R1), (bf16_t*)(ws + WS_U), nullptr};
          pg8::gemm_phase(cx.wv, lds, 512, BRW, 512, S, E); }
        if (!last) { pg8::SchedMergeCtx S{G, c, (const char*)(ws + WS_BR), (const char*)(wl + WO_BR)};
          pg8::EpiMerge E{(const bf16_t*)(ws + WS_R1), (bf16_t*)(ws + WS_U), (bf16_t*)cx.out};
          pg8::gemm_phase(cx.wv, lds, 512, BRW, 512, S, E); } }
    SEAM(P0 + 7);
    if (IN(P0 + 8)) {
        { pg8::Sched2 S{}; S.G = G; S.c = c; S.nM0 = ML / 256; S.nN0 = 4; S.n0 = S.nM0 * S.nN0; S.A0 = (const char*)(ws + WS_U); S.B0 = (const char*)(wl + WO_OUT);
          S.at0 = (size_t)256 * DM * 2; S.bt0 = (size_t)256 * DM * 2; S.n1 = 0;
          pg8::EpiResNorm<(unsigned)(WS_MOD + ((size_t)L * 5 * NMODC + 5 * DM) * 4), (unsigned)(WS_SM + (size_t)(SM_GF2 + L * DM) * 4), (unsigned)(WS_MOD + ((size_t)L * 5 * NMODC + 6 * DM) * 4), (L == 0 ? 2 : 5), last, false> E{ws, HL, lds + LDS_X};
          pg8::gemm_phase(cx.wv, lds, DM, DM, DM, S, E); }
        if (!last) { pg8::SchedSplit S{G, c, 12, (const char*)cx.out, (const char*)(wl + WO_OUT), (size_t)DM * 2, (size_t)DM * 2, 4, (size_t)MC * DM * 2};
          pg8::EpiPart E{(float*)(ws + WS_BR)};
          pg8::gemm_phase(cx.wv, lds, 256, DM, DM, S, E); } }
    SEAM(P0 + 8);
    if (IN(P0 + 9)) { if (!last) norm_phase<0, 12, false>(cx, G, Mlat, sm + SM_GF2 + L * DM, modl, 6, modl + 4 * NMODC + 5 * DM, 1.0f); }
    if (!last) SEAM(P0 + 9);
    if (IN(P0 + 10)) {
        pg8::Sched2 S{}; S.G = G; S.c = c; S.nM0 = Mlat / 256; S.nN0 = 22; S.n0 = S.nM0 * S.nN0; S.A0 = (const char*)(ws + WS_U); S.B0 = (const char*)(wl + WO_13B);
        S.at0 = (size_t)256 * DM * 2; S.bt0 = (size_t)256 * DM * 2; S.n1 = 0;
        pg8::EpiUp E{(bf16_t*)(ws + WS_R1)};
        pg8::gemm_phase(cx.wv, lds, DM, DM, DM, S, E); if ((REPMASK >> (P0 + 10)) & 1u) { xcd_barrier(xb); pg8::gemm_phase(cx.wv, lds, DM, DM, DM, S, E); } }
    SEAM(P0 + 10);
    if (IN(P0 + 11)) {
        pg8::Sched2 S{}; S.G = G; S.c = c; S.nM0 = ML / 256; S.nN0 = 4; S.n0 = S.nM0 * S.nN0; S.A0 = (const char*)(ws + WS_R1); S.B0 = (const char*)(wl + WO_2B);
        S.at0 = (size_t)256 * DFF * 2; S.bt0 = (size_t)256 * DFF * 2; S.n1 = 0;
        if (last) {
            pg8::EpiFinal E{ws, cx.out};
            pg8::gemm_phase(cx.wv, lds, DFF, DFF, DFF, S, E);
        } else {
            { pg8::EpiResNorm<(unsigned)(WS_MOD + ((size_t)0 * 5 * NMODC + 8 * DM) * 4), (unsigned)(WS_SM + (size_t)(SM_GF1 + 1 * DM) * 4), (unsigned)(WS_MOD + ((size_t)1 * 5 * NMODC + 0 * DM) * 4), 3, false, true> E{ws, HL, lds + LDS_X};
              pg8::gemm_phase(cx.wv, lds, DFF, DFF, DFF, S, E); }
            { pg8::SchedSplit S2{G, c, 11, (const char*)(ws + WS_R1) + (size_t)ML * DFF * 2, (const char*)(wl + WO_2B), (size_t)DFF * 2, (size_t)DFF * 2, 11, 0};
              pg8::EpiPart E{(float*)(ws + WS_BR)};
              pg8::gemm_phase(cx.wv, lds, 256, DFF, DFF, S2, E); } } }
    SEAM(P0 + 11);
#undef IN
#undef SEAM
}

__global__ void __launch_bounds__(512, 2) mk_fwd(Args a) {
    extern __shared__ __attribute__((aligned(16))) unsigned char lds_raw[];
    LAS unsigned char* lds = (LAS unsigned char*)lds_raw;
    const int G = gridDim.x, c = blockIdx.x;
    const int lo = a.ph_lo, hi = a.ph_hi;
    volatile LAS unsigned* xst = (volatile LAS unsigned*)(lds + LDS_BYTES - 64);
    const int wv = __builtin_amdgcn_readfirstlane((int)(threadIdx.x >> 6));
    { const int l0 = lane_now(); if (wv == 0 && l0 < 2) xst[l0] = 0u; }
    __syncthreads();
    XcdBarrier xb = xcd_barrier_post((unsigned*)a.ws, xst, wv);
    if (hi > 0x7fff0000) cg::this_grid().sync();
    if (lo == 0) { prep_phase(a, wv, lds, G); if (REPMASK & 1u) { xcd_barrier(xb); prep_phase(a, wv, lds, G); } if (hi > 1) xcd_barrier(xb); }
    Ctx cx; cx.out = a.out; cx.ws = a.ws; cx.x = a.x; cx.ctx = a.ctx; cx.wv = wv;
    layer_phases<0>(cx, xb, lds, G, c, lo, hi);
    layer_phases<1>(cx, xb, lds, G, c, lo, hi);

}

extern "C" void kernel_launch(void* const* d_in, const int* in_sizes, int n_in, void* d_out, int out_size, void* d_ws, size_t ws_size, hipStream_t stream) {
    static int grid = 0;
    if (grid == 0) {
        if (n_in != 19 || out_size != ML * DM || ws_size < WS_END) { fprintf(stderr, "kernel_launch: unexpected shapes: n_in %d out %d ws %zu (need %zu)\n", n_in, out_size, ws_size, (size_t)WS_END); grid = -1; return; }
        int dev = 0, cus = 0, per_cu = 0;
        (void)hipGetDevice(&dev); (void)hipDeviceGetAttribute(&cus, hipDeviceAttributeMultiprocessorCount, dev);
        if (hipFuncSetAttribute((const void*)mk_fwd, hipFuncAttributeMaxDynamicSharedMemorySize, LDS_BYTES) != hipSuccess) { fprintf(stderr, "kernel_launch: hipFuncSetAttribute failed\n"); grid = -1; return; }
        if (hipOccupancyMaxActiveBlocksPerMultiprocessor(&per_cu, (const void*)mk_fwd, 512, LDS_BYTES) != hipSuccess || per_cu < 1) { fprintf(stderr, "kernel_launch: occupancy query says %d\n", per_cu); per_cu = 1; }
        (void)hipGetLastError();
        grid = cus * per_cu;
        fprintf(stderr, "kernel_launch: grid %d (cus %d per_cu %d) ws %zu\n", grid, cus, per_cu, ws_size);
    }
    if (grid < 0) return;
    Args a{};
    a.x = (const float*)d_in[0]; a.c = (const float*)d_in[1]; a.ctx = (const float*)d_in[2]; a.c_ctx = (const float*)d_in[3]; a.w_ada = (const float*)d_in[4]; a.b_ada = (const float*)d_in[5];
    a.g_ffn1 = (const float*)d_in[6]; a.ffn1_w13 = (const float*)d_in[7]; a.ffn1_w2 = (const float*)d_in[8]; a.g_mix = (const float*)d_in[9]; a.w_in = (const float*)d_in[10];
    a.na_bias = (const float*)d_in[11]; a.wa_sink = (const float*)d_in[12]; a.w_br = (const float*)d_in[13]; a.w_out = (const float*)d_in[14]; a.g_ffn2 = (const float*)d_in[15];
    a.ffn2_w13 = (const float*)d_in[16]; a.ffn2_w2 = (const float*)d_in[17]; a.g_final = (const float*)d_in[18];
    a.out = (float*)d_out; a.ws = (unsigned char*)d_ws;
    (void)hipMemsetAsync(d_ws, 0, 16384, stream);
#if MK_MULTI
    for (int ph = 0; ph < N_PHASES; ++ph) { a.ph_lo = ph; a.ph_hi = ph + 1; hipLaunchKernelGGL(mk_fwd, dim3(grid), dim3(512), LDS_BYTES, stream, a); }
#else
    a.ph_lo = 0; a.ph_hi = N_PHASES;
    void* args[] = {&a};
    hipError_t e = hipLaunchCooperativeKernel((const void*)mk_fwd, dim3(grid), dim3(512), args, LDS_BYTES, stream);
    if (e != hipSuccess) fprintf(stderr, "cooperative launch failed: %s (grid %d)\n", hipGetErrorString(e), grid);
#endif
}
```
